# Optimizing an MI355X kernel written in HIP

```python
import math
import jax, jax.numpy as jnp
from jax import lax
import numpy as np

D_MODEL = 2048
BATCH = 4
SEQ = 2048
DEPTH = 2

GRID_W = 64
HEAD_DIM = 128
N_MIX_HEADS = 12
N_KV_HEADS = 4
N_MEM_HEADS = 4
N_MEM = 256
NA_WIN_H = 8
NA_WIN_W = 16
Q_BLOCK = 128
D_FF = 4 * D_MODEL
ROPE_THETA = 10000.0
EPS = 1e-6
N_MIXERS = 2
N_A_LAYERS = (DEPTH + 1) // N_MIXERS
N_B_LAYERS = DEPTH // N_MIXERS
MIX_WIDTH = N_MIX_HEADS * HEAD_DIM
KV_WIDTH = N_KV_HEADS * HEAD_DIM
MEM_WIDTH = N_MEM_HEADS * HEAD_DIM
A_IN_WIDTH = 3 * MIX_WIDTH + MEM_WIDTH
B_IN_WIDTH = MIX_WIDTH + 2 * KV_WIDTH + MEM_WIDTH
CAT_WIDTH = MIX_WIDTH + MEM_WIDTH

kernel_name = "hybrid_natten_axialgqa_encoder"


def rms_norm(x, g):
    xf = x.astype(jnp.float32)
    y = xf * lax.rsqrt(jnp.mean(xf * xf, axis=-1, keepdims=True) + EPS)
    return (y * g.astype(jnp.float32)).astype(x.dtype)


def split_heads(t, n_heads):
    return t.reshape(t.shape[0], t.shape[1], n_heads, HEAD_DIM)


def _rotate(x, ang):
    x1, x2 = jnp.split(x, 2, axis=-1)
    c, s = jnp.cos(ang), jnp.sin(ang)
    return jnp.concatenate([x1 * c - x2 * s, x2 * c + x1 * s], axis=-1)


def axial_rope(x):
    S = x.shape[1]
    t = jnp.arange(S)
    row = (t // GRID_W).astype(jnp.float32)
    col = (t % GRID_W).astype(jnp.float32)
    half = HEAD_DIM // 2
    inv_freq = jnp.power(jnp.float32(ROPE_THETA),
                         -jnp.arange(0, half, 2, dtype=jnp.float32) / half)
    ang_r = (row[:, None] * inv_freq)[:, None, :]
    ang_c = (col[:, None] * inv_freq)[:, None, :]
    xf = x.astype(jnp.float32)
    out = jnp.concatenate([_rotate(xf[..., :half], ang_r),
                           _rotate(xf[..., half:], ang_c)], axis=-1)
    return out.astype(x.dtype)


def neighbourhood_attention(q, k, v, rpb):
    B, S, H, dh = q.shape
    rows = S // GRID_W
    kh = min(NA_WIN_H, rows)
    qg = q.reshape(B, rows, GRID_W, H, dh)
    kg = k.reshape(B, rows, GRID_W, H, dh)
    vg = v.reshape(B, rows, GRID_W, H, dh)
    cols = jnp.arange(GRID_W)
    c0 = jnp.clip(cols - NA_WIN_W // 2, 0, GRID_W - NA_WIN_W)
    col_mask = (cols[None, :] >= c0[:, None]) & (cols[None, :] < c0[:, None] + NA_WIN_W)
    dc_idx = jnp.clip(cols[None, :] - cols[:, None] + NA_WIN_W - 1, 0, 2 * NA_WIN_W - 2)
    scale = HEAD_DIM ** -0.5

    def one_row(r):
        r0 = jnp.clip(r - kh // 2, 0, rows - kh)
        q_r = lax.dynamic_index_in_dim(qg, r, axis=1, keepdims=False)
        k_r = lax.dynamic_slice_in_dim(kg, r0, kh, axis=1)
        v_r = lax.dynamic_slice_in_dim(vg, r0, kh, axis=1)
        dr_idx = r0 + jnp.arange(kh) - r + NA_WIN_H - 1
        bias = rpb[:, dr_idx][:, :, dc_idx]
        bias = bias.transpose(0, 2, 1, 3).astype(jnp.float32)
        s = jnp.einsum('bchd,bikhd->bhcik', q_r, k_r).astype(jnp.float32) * scale + bias[None]
        s = jnp.where(col_mask[None, None, :, None, :], s, -jnp.inf)
        p = jax.nn.softmax(s.reshape(B, H, GRID_W, kh * GRID_W), axis=-1)
        p = p.reshape(B, H, GRID_W, kh, GRID_W).astype(v.dtype)
        return jnp.einsum('bhcik,bikhd->bchd', p, v_r)

    out = lax.map(one_row, jnp.arange(rows))
    return out.transpose(1, 0, 2, 3, 4).reshape(B, S, H * dh)


def gqa_block_attention(q, k, v):
    B, S, H, dh = q.shape
    kvh = k.shape[2]
    g = H // kvh
    nb = S // Q_BLOCK
    qb = q.reshape(B, nb, Q_BLOCK, kvh, g, dh).transpose(1, 0, 3, 4, 2, 5)
    scale = HEAD_DIM ** -0.5

    def one_block(q_blk):
        s = jnp.einsum('bkgqd,bskd->bkgqs', q_blk, k).astype(jnp.float32) * scale
        p = jax.nn.softmax(s, axis=-1).astype(v.dtype)
        return jnp.einsum('bkgqs,bskd->bqkgd', p, v)

    out = lax.map(one_block, qb)
    return out.transpose(1, 0, 2, 3, 4, 5).reshape(B, S, H * dh)


def memory_attention(qm, km, vm):
    B, S, h, dh = qm.shape
    s = jnp.einsum('bshd,bmhd->bhsm', qm, km).astype(jnp.float32) * (HEAD_DIM ** -0.5)
    p = jax.nn.softmax(s, axis=-1).astype(vm.dtype)
    return jnp.einsum('bhsm,bmhd->bshd', p, vm).reshape(B, S, h * dh)


def setup_inputs(seed: int = 0) -> dict:
    key = jax.random.key(seed)
    ks = jax.random.split(key, 16)
    f32 = jnp.float32

    def dense(k, shape, fan_in):
        return jax.random.normal(k, shape, f32) * (fan_in ** -0.5)

    def gain(k, shape):
        return 1.0 + 0.02 * jax.random.normal(k, shape, f32)

    return {
        "x": jax.random.normal(ks[0], (BATCH, SEQ, D_MODEL), f32),
        "mem": jax.random.normal(ks[1], (BATCH, N_MEM, D_MODEL), f32),
        "mem_norm": gain(ks[2], (D_MODEL,)),
        "attn_norm": gain(ks[3], (DEPTH, D_MODEL)),
        "mlp_norm": gain(ks[4], (DEPTH, D_MODEL)),
        "a_w_in": dense(ks[5], (N_A_LAYERS, D_MODEL, A_IN_WIDTH), D_MODEL),
        "a_rpb": 0.1 * jax.random.normal(ks[6], (N_A_LAYERS, N_MIX_HEADS, 2 * NA_WIN_H - 1, 2 * NA_WIN_W - 1), f32),
        "b_w_in": dense(ks[7], (N_B_LAYERS, D_MODEL, B_IN_WIDTH), D_MODEL),
        "b_q_norm": gain(ks[8], (N_B_LAYERS, HEAD_DIM)),
        "b_k_norm": gain(ks[9], (N_B_LAYERS, HEAD_DIM)),
        "w_mem_kv": dense(ks[10], (DEPTH, D_MODEL, 2 * MEM_WIDTH), D_MODEL),
        "w_o": dense(ks[11], (DEPTH, CAT_WIDTH, D_MODEL), CAT_WIDTH),
        "w_up": dense(ks[12], (DEPTH, D_MODEL, D_FF), D_MODEL),
        "w_down": dense(ks[13], (DEPTH, D_FF, D_MODEL), D_FF),
        "final_norm": gain(ks[14], (D_MODEL,)),
    }


def reference(x, mem, mem_norm, attn_norm, mlp_norm, a_w_in, a_rpb, b_w_in, b_q_norm,
              b_k_norm, w_mem_kv, w_o, w_up, w_down, final_norm):
    m = rms_norm(mem, mem_norm)
    h = x
    for i in range(DEPTH):
        n = rms_norm(h, attn_norm[i])
        j = i // N_MIXERS
        if i % N_MIXERS == 0:
            z = n @ a_w_in[j]
            q, k, v, qm = jnp.split(z, [MIX_WIDTH, 2 * MIX_WIDTH, 3 * MIX_WIDTH], axis=-1)
            mix = neighbourhood_attention(split_heads(q, N_MIX_HEADS), split_heads(k, N_MIX_HEADS),
                                          split_heads(v, N_MIX_HEADS), a_rpb[j])
        else:
            z = n @ b_w_in[j]
            q, k, v, qm = jnp.split(z, [MIX_WIDTH, MIX_WIDTH + KV_WIDTH, MIX_WIDTH + 2 * KV_WIDTH], axis=-1)
            q = axial_rope(rms_norm(split_heads(q, N_MIX_HEADS), b_q_norm[j]))
            k = axial_rope(rms_norm(split_heads(k, N_KV_HEADS), b_k_norm[j]))
            mix = gqa_block_attention(q, k, split_heads(v, N_KV_HEADS))
        km, vm = jnp.split(m @ w_mem_kv[i], 2, axis=-1)
        cross = memory_attention(split_heads(qm, N_MEM_HEADS), split_heads(km, N_MEM_HEADS),
                                 split_heads(vm, N_MEM_HEADS))
        h = h + jnp.concatenate([mix, cross], axis=-1) @ w_o[i]
        n = rms_norm(h, mlp_norm[i])
        h = h + jnp.square(jax.nn.relu(n @ w_up[i])) @ w_down[i]
    return rms_norm(h, final_norm)
```

```cpp
#include <hip/hip_runtime.h>
#include <hip/hip_cooperative_groups.h>
#include <cstdio>
#include <cstdint>
namespace cg = cooperative_groups;

#ifndef MK_ONE_LAUNCH
#define MK_ONE_LAUNCH 1
#endif

#define LAS __attribute__((address_space(3)))
typedef unsigned short bf16_t;
typedef short bf16x8 __attribute__((ext_vector_type(8)));
typedef short s16x4 __attribute__((ext_vector_type(4)));
typedef float f32x4 __attribute__((ext_vector_type(4)));
typedef float f32x16 __attribute__((ext_vector_type(16)));
typedef unsigned u32x4 __attribute__((ext_vector_type(4)));

constexpr int DM = 2048, NB = 4, SEQ = 2048, MTOK = NB * SEQ, HD = 128, NMEM = 256, MMEM = NB * NMEM, DFF = 8192;
constexpr int AIN = 5120, BIN = 3072;
constexpr float EPS = 1e-6f;
constexpr int LDS_BYTES = 131072 + 16;
constexpr int NPHASE = 13;

struct Params {
    const float *x, *mem, *mem_norm, *attn_norm, *mlp_norm, *a_w_in, *a_rpb, *b_w_in, *b_q_norm, *b_k_norm, *w_mem_kv, *w_o, *w_up, *w_down, *final_norm;
    float* out;
    bf16_t *wt_in0, *wt_in1, *wt_o, *wt_up, *wt_down;
    bf16_t *acomb;
    bf16_t *z, *cat, *u, *kvm;
    bf16_t* hb2;
    unsigned* bar;
    float* ssq;
};

typedef const Params __attribute__((address_space(4))) CParams;

__device__ __forceinline__ unsigned cvt_pk_bf16(float lo, float hi) { unsigned r; asm volatile("v_cvt_pk_bf16_f32 %0, %1, %2" : "=v"(r) : "v"(lo), "v"(hi)); return r; }
__device__ __forceinline__ float bf_lo(unsigned w) { return __uint_as_float(w << 16); }
__device__ __forceinline__ float bf_hi(unsigned w) { return __uint_as_float(w & 0xffff0000u); }
__device__ __forceinline__ float wave_sum(float v) {
#pragma unroll
    for (int o = 32; o; o >>= 1) v += __shfl_xor(v, o);
    return v;
}

namespace pg8 {
constexpr int BM = 256, BK = 64, HALF = 128, HTB = HALF * BK * 2, STAGE_BYTES = 8 * HTB, NXCD = 8, WGM = 8;
__device__ __forceinline__ int lds_byte(int r, int c) { const int st = (r >> 4) * 2 + (c >> 5), rr = r & 15, cc = c & 31, ob = rr * 64 + cc * 2; return st * 1024 + (ob ^ (((ob >> 9) & 1) << 5)); }
__device__ __forceinline__ void stage_rc(int b, int& R, int& C) { const int st = b / 1024, sb = b % 1024, swz = sb ^ (((sb >> 9) & 1) << 5); R = (st >> 1) * 16 + swz / 64; C = (st & 1) * 32 + (swz % 64) / 2; }
__device__ __forceinline__ int perm32(int rho) { const int n = rho >> 4, i = rho & 15; return 8 * (i >> 2) + 4 * n + (i & 3); }

struct Unit { int pm, pn; };
struct Gemm { const bf16_t* A; const bf16_t* Bt; int K; size_t cstepA, cstepB; };

struct Sched {
    int nM, nN, nwg, G, c;
    int xM0, xnM, xN0, nx;
    __device__ void init(int nM_, int nN_, int G_, int c_) { nM = nM_; nN = nN_; nwg = nM * nN; G = G_; c = c_; xM0 = 0; xnM = 1; xN0 = 0; nx = 0; }
    __device__ bool next(int i, Unit& u) const {
        const int L = i * G + c;
        if (L >= nwg) { const int e = L - nwg; if (e >= nx) return false; u.pm = xM0 + e % xnM; u.pn = xN0 + e / xnM; return true; }
        int wgid = L; { const int q = nwg / NXCD, r = nwg % NXCD, xcd = wgid % NXCD, off = wgid / NXCD; wgid = (xcd < r ? xcd * (q + 1) : r * (q + 1) + (xcd - r) * q) + off; }
        const int nig = WGM * nN, gid = wgid / nig, fm = gid * WGM, gsz = (nM - fm) < WGM ? (nM - fm) : WGM;
        u.pm = fm + ((wgid % nig) % gsz); u.pn = (wgid % nig) / gsz; return true;
    }
};

struct Epi {
    CParams* pp; int ph;
    __device__ __forceinline__ void final_fused(f32x4 (&acc)[2][2][4][2], const Unit& u, int wr, int wc, int fr, int fq) const {
        CParams* q = pp; asm volatile("" : "+s"(q));
        const bf16_t* __restrict__ hb_ = q->acomb; float* slots = q->ssq + (size_t)4 * MTOK * 32; unsigned* cnt = q->bar + 4096 + 64 * u.pm;
        const int row0 = u.pm * BM + wr * 64 + fr, col0 = u.pn * BM + wc * 32 + 8 * fq;
#pragma unroll
        for (int ai = 0; ai < 2; ++ai) {
            u32x4 wv[4][2];
#pragma unroll
            for (int m = 0; m < 4; ++m)
#pragma unroll
                for (int bj = 0; bj < 2; ++bj) wv[m][bj] = *(const u32x4*)(hb_ + (size_t)(row0 + ai * HALF + m * 16) * DM + col0 + bj * HALF);
#pragma unroll
            for (int m = 0; m < 4; ++m) {
                const int row = row0 + ai * HALF + m * 16; float ss = 0.f;
#pragma unroll
                for (int bj = 0; bj < 2; ++bj) { const u32x4 w = wv[m][bj];
                    const f32x4 v0 = acc[ai][bj][m][0] + (f32x4){bf_lo(w.x), bf_hi(w.x), bf_lo(w.y), bf_hi(w.y)}, v1 = acc[ai][bj][m][1] + (f32x4){bf_lo(w.z), bf_hi(w.z), bf_lo(w.w), bf_hi(w.w)};
                    acc[ai][bj][m][0] = v0; acc[ai][bj][m][1] = v1;
                    ss += v0[0] * v0[0] + v0[1] * v0[1] + v0[2] * v0[2] + v0[3] * v0[3] + v1[0] * v1[0] + v1[1] * v1[1] + v1[2] * v1[2] + v1[3] * v1[3]; }
                ss += __shfl_xor(ss, 16); ss += __shfl_xor(ss, 32);
                if (fq == 0) __hip_atomic_store(slots + (size_t)row * 32 + u.pn * 4 + wc, ss, __ATOMIC_RELAXED, __HIP_MEMORY_SCOPE_AGENT);
            }
        }
        asm volatile("s_waitcnt vmcnt(0)" ::: "memory");
        if ((fr | fq) == 0) __hip_atomic_fetch_add(cnt, 1u, __ATOMIC_RELAXED, __HIP_MEMORY_SCOPE_AGENT);
        { unsigned spins = 0;
          while ((unsigned)__builtin_amdgcn_readfirstlane(__hip_atomic_load(cnt, __ATOMIC_RELAXED, __HIP_MEMORY_SCOPE_AGENT)) < 64u) { __builtin_amdgcn_s_sleep(2); if (++spins > (1u << 20)) break; } }
        __builtin_amdgcn_fence(__ATOMIC_ACQUIRE, "agent");
        asm volatile("s_waitcnt vmcnt(0)" ::: "memory");
        float rs8[2][4];
        { f32x4 pa[2][4], pb[2][4];
#pragma unroll
          for (int ai = 0; ai < 2; ++ai)
#pragma unroll
              for (int m = 0; m < 4; ++m) { const float* q8 = slots + (size_t)(row0 + ai * HALF + m * 16) * 32 + fq * 8; pa[ai][m] = *(const f32x4*)q8; pb[ai][m] = *(const f32x4*)(q8 + 4); }
#pragma unroll
          for (int ai = 0; ai < 2; ++ai)
#pragma unroll
              for (int m = 0; m < 4; ++m) { const f32x4 a = pa[ai][m], b = pb[ai][m];
                  float sq = (a[0] + a[1]) + (a[2] + a[3]) + (b[0] + b[1]) + (b[2] + b[3]);
                  sq += __shfl_xor(sq, 16); sq += __shfl_xor(sq, 32);
                  rs8[ai][m] = rsqrtf(sq * (1.f / DM) + EPS); } }
        f32x4 g[2][2];
#pragma unroll
        for (int bj = 0; bj < 2; ++bj) { g[bj][0] = *(const f32x4*)(q->final_norm + col0 + bj * HALF); g[bj][1] = *(const f32x4*)(q->final_norm + col0 + bj * HALF + 4); }
        float* __restrict__ outp = q->out;
#pragma unroll
        for (int ai = 0; ai < 2; ++ai)
#pragma unroll
            for (int m = 0; m < 4; ++m) { const float rs = rs8[ai][m]; float* op = outp + (size_t)(row0 + ai * HALF + m * 16) * DM + col0;
#pragma unroll
                for (int bj = 0; bj < 2; ++bj) { *(f32x4*)(op + bj * HALF) = acc[ai][bj][m][0] * rs * g[bj][0]; *(f32x4*)(op + bj * HALF + 4) = acc[ai][bj][m][1] * rs * g[bj][1]; } }
    }
    __device__ __forceinline__ void operator()(const f32x4 (&acc)[2][2][4][2], const Unit& u, int wr, int wc, int fr, int fq) const {
        CParams* q = pp; asm volatile("" : "+s"(q));
        const int layer = ph >= 6, mode = (ph == 1 || ph == 6) ? 0 : ((ph == 4 || ph == 10) ? 1 : 2);
        bf16_t* O = mode == 0 ? q->z : (mode == 1 ? q->u : ((ph == 5 || ph == 11) ? q->hb2 : q->acomb));
        const int ldc = ph == 1 ? AIN : (ph == 6 ? BIN : DM);
        const float* ssq_in = q->ssq + (size_t)(ph == 1 ? 0 : (ph == 6 ? 2 : (layer ? 3 : 1))) * MTOK * 32;
        const float* hin = q->x;
        const bf16_t* hbin = ph == 3 ? nullptr : (ph == 9 ? q->hb2 : q->acomb);
        float* ssq_out = q->ssq + (size_t)(ph == 3 ? 1 : (ph == 5 ? 2 : (ph == 9 ? 3 : 4))) * MTOK * 32;
        bf16_t* kvm = q->kvm;
        const int row0 = u.pm * BM + wr * 64 + fr, col0 = u.pn * BM + wc * 32 + 8 * fq;
        if (mode == 2) {
            const float* __restrict__ hx = hin; const bf16_t* __restrict__ hb_ = hbin; bf16_t* __restrict__ ob_ = O; float* __restrict__ sq_ = ssq_out;
#pragma unroll
            for (int ai = 0; ai < 2; ++ai)
#pragma unroll
                for (int m = 0; m < 4; ++m) {
                    const int row = row0 + ai * HALF + m * 16; float ss = 0.f;
                    const size_t off0 = (size_t)row * DM + col0;
                    f32x4 h[2][2];
                    if (hb_ == nullptr) {
#pragma unroll
                        for (int bj = 0; bj < 2; ++bj) { h[bj][0] = *(const f32x4*)(hx + off0 + bj * HALF); h[bj][1] = *(const f32x4*)(hx + off0 + bj * HALF + 4); }
                    } else {
#pragma unroll
                        for (int bj = 0; bj < 2; ++bj) { const u32x4 w = *(const u32x4*)(hb_ + off0 + bj * HALF);
                            h[bj][0] = (f32x4){bf_lo(w.x), bf_hi(w.x), bf_lo(w.y), bf_hi(w.y)}; h[bj][1] = (f32x4){bf_lo(w.z), bf_hi(w.z), bf_lo(w.w), bf_hi(w.w)}; }
                    }
#pragma unroll
                    for (int bj = 0; bj < 2; ++bj) {
                        const size_t off = off0 + bj * HALF;
                        const f32x4 v0 = acc[ai][bj][m][0] + h[bj][0], v1 = acc[ai][bj][m][1] + h[bj][1];
                        ss += v0[0] * v0[0] + v0[1] * v0[1] + v0[2] * v0[2] + v0[3] * v0[3] + v1[0] * v1[0] + v1[1] * v1[1] + v1[2] * v1[2] + v1[3] * v1[3];
                        u32x4 w; w.x = cvt_pk_bf16(v0[0], v0[1]); w.y = cvt_pk_bf16(v0[2], v0[3]); w.z = cvt_pk_bf16(v1[0], v1[1]); w.w = cvt_pk_bf16(v1[2], v1[3]);
                        *(u32x4*)(ob_ + off) = w;
                    }
                    ss += __shfl_xor(ss, 16); ss += __shfl_xor(ss, 32);
                    if (fq == 0) sq_[(size_t)row * 32 + u.pn * 4 + wc] = ss;
                }
        } else {
            const bool extra = u.pm >= 32;
            bf16_t* base = O; int ld = ldc, r0 = row0, c0 = col0;
            if (mode == 1) { const int ch = u.pn >> 3; base += (size_t)ch * ((size_t)MTOK * DM); c0 -= ch * DM; }
            if (extra) { const int j = (u.pn - 20) >> 2; base = kvm + (size_t)j * (MMEM * 1024); ld = 1024; r0 = row0 - MTOK; c0 = col0 - AIN - j * 1024; }
#pragma unroll
            for (int ai = 0; ai < 2; ++ai)
#pragma unroll
                for (int m = 0; m < 4; ++m) {
                    const int row = r0 + ai * HALF + m * 16;
                    float rs = 1.f;
                    if (!extra) { const f32x4 a = *(const f32x4*)(ssq_in + (size_t)row * 32 + fq * 8), b = *(const f32x4*)(ssq_in + (size_t)row * 32 + fq * 8 + 4);
                        float sq = (a[0] + a[1]) + (a[2] + a[3]) + (b[0] + b[1]) + (b[2] + b[3]);
                        sq += __shfl_xor(sq, 16); sq += __shfl_xor(sq, 32);
                        rs = rsqrtf(sq * (1.f / DM) + EPS); }
                    bf16_t* rowp = base + (size_t)row * ld + c0;
#pragma unroll
                    for (int bj = 0; bj < 2; ++bj) {
                        f32x4 v0 = acc[ai][bj][m][0] * rs, v1 = acc[ai][bj][m][1] * rs;
                        if (mode == 1) {
#pragma unroll
                            for (int j = 0; j < 4; ++j) { const float a = fmaxf(v0[j], 0.f), b = fmaxf(v1[j], 0.f); v0[j] = a * a; v1[j] = b * b; }
                        }
                        u32x4 w; w.x = cvt_pk_bf16(v0[0], v0[1]); w.y = cvt_pk_bf16(v0[2], v0[3]); w.z = cvt_pk_bf16(v1[0], v1[1]); w.w = cvt_pk_bf16(v1[2], v1[3]);
                        *(u32x4*)(rowp + bj * HALF) = w;
                    }
                }
        }
    }
};

__device__ __forceinline__ void gemm_phase(const int tid, LAS unsigned char* lds, const Gemm g, const Sched& S, const Epi& E) {
    const int wid = __builtin_amdgcn_readfirstlane(tid >> 6), lane = tid & 63, wr = wid >> 2, wc = wid & 3, fr = lane & 15, fq = lane >> 4;
    const int K = g.K, nt = K / BK;
    unsigned voffA[2], voffB[2];
#pragma unroll
    for (int i = 0; i < 2; ++i) { int R, C; stage_rc(tid * 16 + i * 8192, R, C); const int Rb = (R & ~31) + perm32(R & 31);
        voffA[i] = (unsigned)(R * DM + C) * 2u; voffB[i] = (unsigned)(Rb * DM + C) * 2u; }
    const size_t kstep = (size_t)(BK * 2);
    const size_t hstep = (size_t)HALF * DM * 2;
    const size_t cstepA = g.cstepA, cstepB = g.cstepB;
#define PG8_OFFA(t) ((size_t)((t) >> 5) * cstepA + (size_t)((t) & 31) * kstep)
#define PG8_OFFB(t) ((size_t)((t) >> 5) * cstepB + (size_t)((t) & 31) * kstep)
    const size_t tstep = 2 * hstep;
    const unsigned ldsw = (unsigned)wid * 1024u;
    const int aoff = lds_byte(wr * 64 + fr, fq * 8), boff = lds_byte(wc * 32 + fr, fq * 8);
#define PG8_SA(b, h) (((b) * 2 + (h)) * HTB)
#define PG8_SB(b, h) ((4 + (b) * 2 + (h)) * HTB)
#define PG8_STAGE(bufoff, gbase, voff) do { _Pragma("unroll") for (int _i = 0; _i < 2; ++_i) \
        __builtin_amdgcn_global_load_lds((const unsigned*)((const char*)(gbase) + (voff)[_i]), (LAS unsigned*)(lds + (bufoff) + ldsw + _i * 8192), 16, 0, 0); } while (0)
#define PG8_LDA(dst, b, h) do { _Pragma("unroll") for (int m = 0; m < 4; ++m) _Pragma("unroll") for (int k = 0; k < 2; ++k) dst[m][k] = *(const LAS bf16x8*)(lds + PG8_SA(b, h) + aoff + m * 2048 + k * 1024); } while (0)
#define PG8_LDB(dst, b, h) do { _Pragma("unroll") for (int n = 0; n < 2; ++n) _Pragma("unroll") for (int k = 0; k < 2; ++k) dst[n][k] = *(const LAS bf16x8*)(lds + PG8_SB(b, h) + boff + n * 2048 + k * 1024); } while (0)
#define PG8_MMA(ai, bj, At, Bt) do { __builtin_amdgcn_s_setprio(1); _Pragma("unroll") for (int m = 0; m < 4; ++m) _Pragma("unroll") for (int n = 0; n < 2; ++n) _Pragma("unroll") for (int k = 0; k < 2; ++k) \
        acc[ai][bj][m][n] = __builtin_amdgcn_mfma_f32_16x16x32_bf16(Bt[n][k], At[m][k], acc[ai][bj][m][n], 0, 0, 0); __builtin_amdgcn_s_setprio(0); } while (0)
#define PG8_WAIT_V(n) asm volatile("s_waitcnt vmcnt(" #n ")" ::: "memory")
#define PG8_WAIT_L(n) asm volatile("s_waitcnt lgkmcnt(" #n ")" ::: "memory")
#define PG8_BAR __builtin_amdgcn_s_barrier()
#define PG8_SCHED __builtin_amdgcn_sched_barrier(0)
    Unit cur, nxt; int ui = 0;
    if (!S.next(0, cur)) return;
    f32x4 acc[2][2][4][2];
#pragma unroll
    for (int a = 0; a < 2; ++a)
#pragma unroll
        for (int b = 0; b < 2; ++b)
#pragma unroll
            for (int m = 0; m < 4; ++m)
#pragma unroll
                for (int n = 0; n < 2; ++n) acc[a][b][m][n] = (f32x4){0.f, 0.f, 0.f, 0.f};
    bf16x8 At[4][2], B0[2][2], B1[2][2];
    const char* cA = (const char*)g.A + (size_t)cur.pm * tstep; const char* cB = (const char*)g.Bt + (size_t)cur.pn * tstep;
    PG8_STAGE(PG8_SB(0, 0), cB, voffB); PG8_STAGE(PG8_SA(0, 0), cA, voffA); PG8_STAGE(PG8_SB(0, 1), cB + hstep, voffB); PG8_STAGE(PG8_SA(0, 1), cA + hstep, voffA);
    if (wr == 1) PG8_BAR;
    PG8_WAIT_V(4); PG8_BAR;
    PG8_STAGE(PG8_SB(1, 0), cB + kstep, voffB); PG8_STAGE(PG8_SA(1, 0), cA + kstep, voffA); PG8_STAGE(PG8_SB(1, 1), cB + hstep + kstep, voffB);
    PG8_WAIT_V(6); PG8_BAR;
    for (;;) {
        const bool has_next = S.next(ui + 1, nxt);
        const char* nA = has_next ? (const char*)g.A + (size_t)nxt.pm * tstep : cA; const char* nB = has_next ? (const char*)g.Bt + (size_t)nxt.pn * tstep : cB;
        for (int t = 0; t < nt; t += 2) {
            const bool last = (t == nt - 2);
            const char* a1 = cA + PG8_OFFA(t + 1);
            const char* a2 = last ? nA : cA + PG8_OFFA(t + 2); const char* b2 = last ? nB : cB + PG8_OFFB(t + 2);
            const char* a3 = a2 + kstep; const char* b3 = b2 + kstep;
            PG8_LDB(B0, 0, 0); PG8_SCHED; PG8_LDA(At, 0, 0); PG8_STAGE(PG8_SA(1, 1), a1 + hstep, voffA);
            PG8_WAIT_L(8); PG8_BAR; PG8_WAIT_L(0); PG8_MMA(0, 0, At, B0); PG8_BAR; PG8_SCHED;
            PG8_LDB(B1, 0, 1); PG8_STAGE(PG8_SB(0, 0), b2, voffB);
            PG8_BAR; PG8_WAIT_L(0); PG8_MMA(0, 1, At, B1); PG8_BAR;
            PG8_LDA(At, 0, 1); PG8_STAGE(PG8_SA(0, 0), a2, voffA);
            PG8_BAR; PG8_WAIT_L(0); PG8_MMA(1, 0, At, B0); PG8_BAR; PG8_SCHED;
            PG8_STAGE(PG8_SB(0, 1), b2 + hstep, voffB);
            PG8_WAIT_V(6); PG8_BAR; PG8_MMA(1, 1, At, B1); PG8_BAR;
            PG8_LDB(B0, 1, 0); PG8_SCHED; PG8_LDA(At, 1, 0); PG8_STAGE(PG8_SA(0, 1), a2 + hstep, voffA);
            PG8_WAIT_L(8); PG8_BAR; PG8_WAIT_L(0); PG8_MMA(0, 0, At, B0); PG8_BAR; PG8_SCHED;
            PG8_LDB(B1, 1, 1); PG8_STAGE(PG8_SB(1, 0), b3, voffB);
            PG8_BAR; PG8_WAIT_L(0); PG8_MMA(0, 1, At, B1); PG8_BAR;
            PG8_LDA(At, 1, 1); PG8_STAGE(PG8_SA(1, 0), a3, voffA);
            PG8_BAR; PG8_WAIT_L(0); PG8_MMA(1, 0, At, B0); PG8_BAR; PG8_SCHED;
            PG8_STAGE(PG8_SB(1, 1), b3 + hstep, voffB);
            PG8_WAIT_V(6); PG8_BAR; PG8_MMA(1, 1, At, B1); PG8_BAR;
        }
        const bool fusedfinal = (E.ph == 11) && (gridDim.x == 256);
        if (!fusedfinal) E(acc, cur, wr, wc, fr, fq);
        if (!has_next) break;
#pragma unroll
        for (int a = 0; a < 2; ++a)
#pragma unroll
            for (int b = 0; b < 2; ++b)
#pragma unroll
                for (int m = 0; m < 4; ++m)
#pragma unroll
                    for (int n = 0; n < 2; ++n) acc[a][b][m][n] = (f32x4){0.f, 0.f, 0.f, 0.f};
        cur = nxt; cA = nA; cB = nB; ++ui;
    }
    PG8_WAIT_V(0);
    if (wr == 0) PG8_BAR;
    PG8_BAR;
    if ((E.ph == 11) && (gridDim.x == 256)) E.final_fused(acc, cur, wr, wc, fr, fq);
#undef PG8_OFFA
#undef PG8_OFFB
#undef PG8_SA
#undef PG8_SB
#undef PG8_STAGE
#undef PG8_LDA
#undef PG8_LDB
#undef PG8_MMA
#undef PG8_WAIT_V
#undef PG8_WAIT_L
#undef PG8_BAR
#undef PG8_SCHED
}
}

namespace at {
constexpr int D = 128, NW = 8, QBLK = 32, KVBLK = 64;
constexpr float SCALE = 0.088388347648318440f;
constexpr float THR = 8.f;
constexpr size_t SHM_V = KVBLK * D * 2, SHM_K = KVBLK * D * 2, SHM_ATTN = 2 * SHM_V + 2 * SHM_K + NW * 64 * 4;
constexpr int TB_OFF = (int)SHM_ATTN, TB_FLOATS = 640;
#define KSWZ(row, colB) ((row) * 256 + ((colB) ^ (((row) & 7) << 4)))
#define SBAR() __builtin_amdgcn_sched_barrier(0)
__device__ __forceinline__ int crow(int r, int hi) { return (r & 3) + 8 * (r >> 2) + 4 * hi; }

__device__ __forceinline__ void partialSM(f32x16& p0, f32x16& p1, float& m_reg, float& mn, float& alpha) {
    constexpr float C = SCALE * 1.4426950408889634f;
    float pmax = p0[0];
#pragma unroll
    for (int r = 1; r < 16; ++r) pmax = fmaxf(pmax, p0[r]);
#pragma unroll
    for (int r = 0; r < 16; ++r) pmax = fmaxf(pmax, p1[r]);
    { auto rr = __builtin_amdgcn_permlane32_swap(__float_as_uint(pmax), __float_as_uint(pmax), false, false);
      pmax = fmaxf(__uint_as_float(rr[0]), __uint_as_float(rr[1])); }
    if (__builtin_expect(__all(pmax - m_reg <= THR / SCALE), 1)) { mn = m_reg; alpha = 1.f; }
    else { mn = fmaxf(m_reg, pmax); alpha = __builtin_amdgcn_exp2f((m_reg - mn) * C); m_reg = mn; }
    const float mnC = -mn * C;
#pragma unroll
    for (int r = 0; r < 16; ++r) p0[r] = fmaf(p0[r], C, mnC);
#pragma unroll
    for (int r = 0; r < 16; ++r) p1[r] = fmaf(p1[r], C, mnC);
#pragma unroll
    for (int r = 0; r < 16; ++r) p0[r] = __builtin_amdgcn_exp2f(p0[r]);
}
__device__ __forceinline__ void finishSM(f32x16& p0, f32x16& p1, float alpha, float& l_reg, bf16x8& pa0, bf16x8& pa1, bf16x8& pa2, bf16x8& pa3) {
#pragma unroll
    for (int r = 0; r < 16; ++r) p1[r] = __builtin_amdgcn_exp2f(p1[r]);
    float ps = 0;
#pragma unroll
    for (int r = 0; r < 16; ++r) ps += p0[r];
#pragma unroll
    for (int r = 0; r < 16; ++r) ps += p1[r];
    { auto rr = __builtin_amdgcn_permlane32_swap(__float_as_uint(ps), __float_as_uint(ps), false, false);
      ps = __uint_as_float(rr[0]) + __uint_as_float(rr[1]); }
    l_reg = l_reg * alpha + ps;
#define PK4(P, BASE, OUT) do { unsigned a0 = cvt_pk_bf16(P[BASE + 0], P[BASE + 1]), a1 = cvt_pk_bf16(P[BASE + 2], P[BASE + 3]);   \
    unsigned b0 = cvt_pk_bf16(P[BASE + 4], P[BASE + 5]), b1 = cvt_pk_bf16(P[BASE + 6], P[BASE + 7]);                              \
    auto r0 = __builtin_amdgcn_permlane32_swap(a0, b0, false, false); auto r1 = __builtin_amdgcn_permlane32_swap(a1, b1, false, false); \
    u32x4 w = {r0[0], r1[0], r0[1], r1[1]}; OUT = *reinterpret_cast<bf16x8*>(&w); } while (0)
    PK4(p0, 0, pa0); PK4(p0, 8, pa1); PK4(p1, 0, pa2); PK4(p1, 8, pa3);
#undef PK4
}
__device__ __forceinline__ void qkt(f32x16& p0, f32x16& p1, const bf16_t* Ks, const bf16x8* qr, int r32, int hi) {
    p0 = f32x16{}; p1 = f32x16{};
#pragma unroll
    for (int d0 = 0; d0 < 8; ++d0) { const int cb = (d0 * 16 + hi * 8) * 2;
        bf16x8 b0 = *reinterpret_cast<const bf16x8*>((const char*)Ks + KSWZ(r32, cb));
        bf16x8 b1 = *reinterpret_cast<const bf16x8*>((const char*)Ks + KSWZ(32 + r32, cb));
        p0 = __builtin_amdgcn_mfma_f32_32x32x16_bf16(b0, qr[d0], p0, 0, 0, 0);
        p1 = __builtin_amdgcn_mfma_f32_32x32x16_bf16(b1, qr[d0], p1, 0, 0, 0); }
}
__device__ __forceinline__ int v_st(int k, int c) { const int kk = (k & ~0xC) | ((k & 4) << 1) | ((k & 8) >> 1); return ((kk >> 3) * 4 + (c >> 5)) * 512 + ((kk & 7) * 32 + (c & 31)) * 2; }
__device__ __forceinline__ int v_rd_base(int lane) { return ((lane & 3) << 3) | (((lane >> 2) & 3) << 6) | (((lane >> 4) & 1) << 5) | (((lane >> 5) & 1) << 8); }
constexpr int v_rd_off(int d0, int ks, int half) { return d0 * 512 + ks * 4096 + half * 2048; }
template <int OFF> __device__ __forceinline__ s16x4 tr_read(int vb) {
    s16x4 r; asm volatile("ds_read_b64_tr_b16 %0, %1 offset:%2" : "=&v"(r) : "v"(vb), "i"(OFF) : "memory"); return r;
}
template <int D0> __device__ __forceinline__ void pv_one(f32x16& od, int vb, bf16x8 pa0, bf16x8 pa1, bf16x8 pa2, bf16x8 pa3) {
    const s16x4 l0 = tr_read<v_rd_off(D0, 0, 0)>(vb), h0 = tr_read<v_rd_off(D0, 0, 1)>(vb), l1 = tr_read<v_rd_off(D0, 1, 0)>(vb), h1 = tr_read<v_rd_off(D0, 1, 1)>(vb);
    const s16x4 l2 = tr_read<v_rd_off(D0, 2, 0)>(vb), h2 = tr_read<v_rd_off(D0, 2, 1)>(vb), l3 = tr_read<v_rd_off(D0, 3, 0)>(vb), h3 = tr_read<v_rd_off(D0, 3, 1)>(vb);
    asm volatile("s_waitcnt lgkmcnt(0)" ::: "memory"); SBAR();
#define PK(L, H) (bf16x8){L[0], L[1], L[2], L[3], H[0], H[1], H[2], H[3]}
    od = __builtin_amdgcn_mfma_f32_32x32x16_bf16(pa0, PK(l0, h0), od, 0, 0, 0);
    od = __builtin_amdgcn_mfma_f32_32x32x16_bf16(pa1, PK(l1, h1), od, 0, 0, 0);
    od = __builtin_amdgcn_mfma_f32_32x32x16_bf16(pa2, PK(l2, h2), od, 0, 0, 0);
    od = __builtin_amdgcn_mfma_f32_32x32x16_bf16(pa3, PK(l3, h3), od, 0, 0, 0);
#undef PK
}
__device__ __forceinline__ void pv_d0(f32x16* o, int vb, bf16x8 pa0, bf16x8 pa1, bf16x8 pa2, bf16x8 pa3) {
    pv_one<0>(o[0], vb, pa0, pa1, pa2, pa3); pv_one<1>(o[1], vb, pa0, pa1, pa2, pa3); pv_one<2>(o[2], vb, pa0, pa1, pa2, pa3); pv_one<3>(o[3], vb, pa0, pa1, pa2, pa3);
}
__device__ __forceinline__ void na_hook(f32x16& p0, f32x16& p1, int j, int tlo, int cmpb, const LAS float* tbl) {
    const float NINF = -__builtin_inff();
    const int cb = ((unsigned)(j - tlo) < 8u) ? cmpb : 4096;
    const volatile LAS float* t = tbl + j * 31;
#pragma unroll
    for (int rg = 0; rg < 4; ++rg) {
#pragma unroll
        for (int rr = 0; rr < 4; ++rr) { const int r = rg * 4 + rr, kc = rr + 8 * rg;
            const float b0 = t[kc], b1 = t[kc + 32];
            p0[r] = ((unsigned)(kc + cb) < 16u) ? p0[r] + b0 : NINF;
            p1[r] = ((unsigned)(kc + 32 + cb) < 16u) ? p1[r] + b1 : NINF; }
        SBAR();
    }
}

__device__ __forceinline__ void attn_body(const int tid, const bool NA, const bf16_t* __restrict__ Qb, int ldq, const bf16_t* __restrict__ Kh, const bf16_t* __restrict__ Vh, int ldk,
                                          bf16_t* __restrict__ Ob, int ldo, int NT, char* lds, int tlo, int cmpb, const LAS float* tbl) {
    const int wid = __builtin_amdgcn_readfirstlane(tid >> 6), lane = tid & 63, r32 = lane & 31, hi = lane >> 5;
    bf16_t* V_lds = (bf16_t*)lds; bf16_t* K_lds = (bf16_t*)(lds + 2 * SHM_V);
    float* ws = (float*)(lds + 2 * SHM_V + 2 * SHM_K) + wid * 64; float* li_l = ws; float* al_l = ws + 32;
    float m_reg = -1e30f, l_reg = 0; f32x16 o[4] = {}; bf16x8 qr[8];
    const bf16_t* Qw = Qb + (size_t)(wid * QBLK + r32) * ldq + hi * 8;
#pragma unroll
    for (int d0 = 0; d0 < 8; ++d0) qr[d0] = *reinterpret_cast<const bf16x8*>(Qw + d0 * 16);
    const int sr = tid >> 4, sc = (tid & 15) * 8, vst0 = v_st(sr, sc), vst1 = v_st(32 + sr, sc);
    const int vb0 = (int)(uintptr_t)V_lds + v_rd_base(lane);
    constexpr int SDEPTH = 1;
    struct { bf16x8 vs0, vs1, ks0, ks1; } sr_[SDEPTH];
    const unsigned vo0 = (unsigned)(sr * ldk + sc) * 2u, vo1 = vo0 + (unsigned)(32 * ldk) * 2u;
    const char* Kc = (const char*)Kh; const char* Vc = (const char*)Vh; const size_t tile_b = (size_t)KVBLK * ldk * 2;
#define SLOAD(i, t) do { const char* kb_ = Kc + (size_t)(t) * tile_b; const char* vb_ = Vc + (size_t)(t) * tile_b; \
    sr_[i].vs0 = *reinterpret_cast<const bf16x8*>(vb_ + vo0); sr_[i].vs1 = *reinterpret_cast<const bf16x8*>(vb_ + vo1); \
    sr_[i].ks0 = *reinterpret_cast<const bf16x8*>(kb_ + vo0); sr_[i].ks1 = *reinterpret_cast<const bf16x8*>(kb_ + vo1); } while (0)
#define SWRITE(b, i) do { *(bf16x8*)((char*)V_lds + (b) * SHM_V + vst0) = sr_[i].vs0;          \
    *(bf16x8*)((char*)V_lds + (b) * SHM_V + vst1) = sr_[i].vs1; int kc = sc * 2;               \
    *(bf16x8*)((char*)K_lds + (b) * SHM_K + KSWZ(sr, kc)) = sr_[i].ks0;                       \
    *(bf16x8*)((char*)K_lds + (b) * SHM_K + KSWZ(32 + sr, kc)) = sr_[i].ks1; } while (0)
#define SWAIT() do { if constexpr (SDEPTH == 2) asm volatile("s_waitcnt vmcnt(4)" ::: "memory"); else asm volatile("s_waitcnt vmcnt(0)" ::: "memory"); } while (0)
#define RESC(a) do { if (__any((a) < 1.f)) { if (hi == 0) al_l[r32] = (a); asm volatile("s_waitcnt lgkmcnt(0)" ::: "memory"); \
    _Pragma("unroll") for (int d = 0; d < 4; ++d) _Pragma("unroll") for (int r = 0; r < 16; ++r) o[d][r] *= al_l[crow(r, hi)]; } } while (0)
#define HOOK(P0, P1, J) do { if (NA) na_hook(P0, P1, (J), tlo, cmpb, tbl); } while (0)
    f32x16 pA0, pA1, pB0, pB1; float mnA, mnB, alA, alB; bf16x8 pa0, pa1, pa2, pa3;
    constexpr int SE = 0, SO = SDEPTH - 1;
    SLOAD(SE, 0); asm volatile("s_waitcnt vmcnt(0)" ::: "memory"); SWRITE(0, SE); __syncthreads();
    qkt(pA0, pA1, K_lds, qr, r32, hi); HOOK(pA0, pA1, 0); partialSM(pA0, pA1, m_reg, mnA, alA);
    SLOAD(SO, 1); if constexpr (SDEPTH == 2) { if (2 < NT) SLOAD(SE, 2); }
    SWAIT(); SWRITE(1, SO); __syncthreads();
    for (int j = 1; j + 1 < NT; j += 2) {
        SBAR(); qkt(pB0, pB1, (bf16_t*)((char*)K_lds + SHM_K), qr, r32, hi); HOOK(pB0, pB1, j);
        finishSM(pA0, pA1, alA, l_reg, pa0, pa1, pa2, pa3); SBAR();
        SLOAD(SO, j + SDEPTH); SBAR();
        pv_d0(o, vb0, pa0, pa1, pa2, pa3); partialSM(pB0, pB1, m_reg, mnB, alB);
        __syncthreads(); SWAIT(); SWRITE(0, SE);
        RESC(alB); __syncthreads();
        SBAR(); qkt(pA0, pA1, K_lds, qr, r32, hi); HOOK(pA0, pA1, j + 1);
        finishSM(pB0, pB1, alB, l_reg, pa0, pa1, pa2, pa3); SBAR();
        if (SDEPTH == 1 || j + 3 < NT) SLOAD(SE, j + 1 + SDEPTH); SBAR();
        pv_d0(o, vb0 + (int)SHM_V, pa0, pa1, pa2, pa3); partialSM(pA0, pA1, m_reg, mnA, alA);
        __syncthreads(); SWAIT(); SWRITE(1, SO);
        RESC(alA); __syncthreads();
    }
    SBAR(); qkt(pB0, pB1, (bf16_t*)((char*)K_lds + SHM_K), qr, r32, hi); HOOK(pB0, pB1, NT - 1);
    finishSM(pA0, pA1, alA, l_reg, pa0, pa1, pa2, pa3); SBAR();
    pv_d0(o, vb0, pa0, pa1, pa2, pa3); partialSM(pB0, pB1, m_reg, mnB, alB);
    __syncthreads(); RESC(alB);
    finishSM(pB0, pB1, alB, l_reg, pa0, pa1, pa2, pa3); SBAR();
    pv_d0(o, vb0 + (int)SHM_V, pa0, pa1, pa2, pa3);
    if (hi == 0) li_l[r32] = l_reg; asm volatile("s_waitcnt lgkmcnt(0)" ::: "memory");
    float rli[16];
#pragma unroll
    for (int r = 0; r < 16; ++r) rli[r] = __builtin_amdgcn_rcpf(li_l[crow(r, hi)]);
    bf16_t* Ow = Ob + (size_t)(wid * QBLK) * ldo;
#pragma unroll
    for (int r = 0; r < 16; ++r) { const int orow = crow(r, hi);
#pragma unroll
        for (int d0 = 0; d0 < 4; ++d0) Ow[(size_t)orow * ldo + d0 * 32 + r32] = (bf16_t)(cvt_pk_bf16(o[d0][r] * rli[r], 0.f) & 0xffffu); }
#undef SLOAD
#undef SWRITE
#undef SWAIT
#undef RESC
#undef HOOK
}
}

__device__ __forceinline__ void wt_tile(const float* __restrict__ W, int N, bf16_t* __restrict__ Bt, int ldb, const float* __restrict__ g, int tk, int tn, unsigned* s, const int tid) {
    const int kp = tid >> 5, n4 = (tid & 31) * 4;
    f32x4 a[4], b[4];
#pragma unroll
    for (int pass = 0; pass < 4; ++pass) {
        const int k = tk * 128 + (pass * 16 + kp) * 2;
        const float* src = W + (size_t)k * N + tn * 128 + n4;
        a[pass] = __builtin_nontemporal_load((const f32x4*)src); b[pass] = __builtin_nontemporal_load((const f32x4*)(src + N));
    }
#pragma unroll
    for (int pass = 0; pass < 4; ++pass) {
        const int kpp = pass * 16 + kp, k = tk * 128 + kpp * 2;
        const float g0 = g ? g[k] : 1.f, g1 = g ? g[k + 1] : 1.f;
        s[(n4 + 0) * 65 + kpp] = cvt_pk_bf16(a[pass][0] * g0, b[pass][0] * g1);
        s[(n4 + 1) * 65 + kpp] = cvt_pk_bf16(a[pass][1] * g0, b[pass][1] * g1);
        s[(n4 + 2) * 65 + kpp] = cvt_pk_bf16(a[pass][2] * g0, b[pass][2] * g1);
        s[(n4 + 3) * 65 + kpp] = cvt_pk_bf16(a[pass][3] * g0, b[pass][3] * g1);
    }
    __syncthreads();
    const int ks = tid & 15;
#pragma unroll
    for (int pass = 0; pass < 4; ++pass) {
        const int n = pass * 32 + (tid >> 4);
        u32x4 w; w.x = s[n * 65 + ks * 4 + 0]; w.y = s[n * 65 + ks * 4 + 1]; w.z = s[n * 65 + ks * 4 + 2]; w.w = s[n * 65 + ks * 4 + 3];
        *(u32x4*)(Bt + (size_t)(tn * 128 + n) * ldb + ks * 8) = w;
    }
    __syncthreads();
}

__device__ __forceinline__ void prep_phase(const int tid, CParams* pp, unsigned char* shm) {
    const int lane = tid & 63, wid = tid >> 6;
    const int gw = blockIdx.x * 8 + wid, nw = gridDim.x * 8;
    for (int row = gw; row < MTOK; row += nw) {
        const float* xr = pp->x + (size_t)row * DM; bf16_t* hr = pp->acomb + (size_t)row * DM; float s = 0.f;
#pragma unroll
        for (int i = 0; i < 4; ++i) { const int c = (i * 64 + lane) * 8;
            const f32x4 a = *(const f32x4*)(xr + c), b = *(const f32x4*)(xr + c + 4);
            s += a[0] * a[0] + a[1] * a[1] + a[2] * a[2] + a[3] * a[3] + b[0] * b[0] + b[1] * b[1] + b[2] * b[2] + b[3] * b[3];
            u32x4 w; w.x = cvt_pk_bf16(a[0], a[1]); w.y = cvt_pk_bf16(a[2], a[3]); w.z = cvt_pk_bf16(b[0], b[1]); w.w = cvt_pk_bf16(b[2], b[3]);
            *(u32x4*)(hr + c) = w; }
        s += __shfl_xor(s, 32);
        if (lane < 32) pp->ssq[(size_t)row * 32 + lane] = s;
    }
    for (int row = gw; row < MMEM; row += nw) {
        const float* xr = pp->mem + (size_t)row * DM; bf16_t* hr = pp->acomb + (size_t)(MTOK + row) * DM; float s = 0.f;
        f32x4 a[4], b[4];
#pragma unroll
        for (int i = 0; i < 4; ++i) { const int c = (i * 64 + lane) * 8; a[i] = *(const f32x4*)(xr + c); b[i] = *(const f32x4*)(xr + c + 4);
            s += a[i][0] * a[i][0] + a[i][1] * a[i][1] + a[i][2] * a[i][2] + a[i][3] * a[i][3] + b[i][0] * b[i][0] + b[i][1] * b[i][1] + b[i][2] * b[i][2] + b[i][3] * b[i][3]; }
        s = wave_sum(s);
        const float rs = rsqrtf(s * (1.f / DM) + EPS);
#pragma unroll
        for (int i = 0; i < 4; ++i) { const int c = (i * 64 + lane) * 8;
            const f32x4 ga = *(const f32x4*)(pp->mem_norm + c), gb = *(const f32x4*)(pp->mem_norm + c + 4);
            u32x4 w; w.x = cvt_pk_bf16(a[i][0] * rs * ga[0], a[i][1] * rs * ga[1]); w.y = cvt_pk_bf16(a[i][2] * rs * ga[2], a[i][3] * rs * ga[3]);
            w.z = cvt_pk_bf16(b[i][0] * rs * gb[0], b[i][1] * rs * gb[1]); w.w = cvt_pk_bf16(b[i][2] * rs * gb[2], b[i][3] * rs * gb[3]);
            *(u32x4*)(hr + c) = w; }
    }
}

__device__ __forceinline__ void convert_jobs(const int tid, CParams* pp, unsigned char* shm, const int mask, const int rank, const int nranks) {
    unsigned* s = (unsigned*)shm;
    int t = rank;
#pragma unroll 1
    for (int job = 0; job < 10; ++job) {
        if (!((mask >> job) & 1)) continue;
        const float* W; const float* g = nullptr; bf16_t* Bt; int K = DM, N;
        switch (job) {
            case 0: W = pp->a_w_in; N = AIN; Bt = pp->wt_in0; g = pp->attn_norm; break;
            case 1: W = pp->w_mem_kv; N = 1024; Bt = pp->wt_in0 + (size_t)AIN * DM; break;
            case 2: W = pp->w_mem_kv + (size_t)DM * 1024; N = 1024; Bt = pp->wt_in0 + (size_t)(AIN + 1024) * DM; break;
            case 3: W = pp->b_w_in; N = BIN; Bt = pp->wt_in1; g = pp->attn_norm + DM; break;
            case 4: W = pp->w_o; N = DM; Bt = pp->wt_o; break;
            case 5: W = pp->w_o + (size_t)DM * DM; N = DM; Bt = pp->wt_o + (size_t)DM * DM; break;
            case 6: W = pp->w_up; N = DFF; Bt = pp->wt_up; g = pp->mlp_norm; break;
            case 7: W = pp->w_up + (size_t)DM * DFF; N = DFF; Bt = pp->wt_up + (size_t)DM * DFF; g = pp->mlp_norm + DM; break;
            case 8: W = pp->w_down; K = DFF; N = DM; Bt = pp->wt_down; break;
            default: W = pp->w_down + (size_t)DFF * DM; K = DFF; N = DM; Bt = pp->wt_down + (size_t)DFF * DM; break;
        }
        const int ntn = N / 128, ntiles = (K / 128) * ntn;
        for (; t < ntiles; t += nranks) { const int tk = t / ntn, k0 = tk * 128;
            bf16_t* dst = (K == DFF) ? Bt + (size_t)(k0 >> 11) * ((size_t)DM * DM) + (k0 & (DM - 1)) : Bt + k0;
            wt_tile(W, N, dst, DM, g, tk, t % ntn, s, tid); }
        t -= ntiles;
    }
}

__device__ __forceinline__ void qknorm_rope_phase(const int tid, CParams* pp) {
    const int lane = tid & 63, wid = tid >> 6, l16 = lane & 15;
    const int head = (wid & 3) * 4 + (lane >> 4);
    const float* gsrc = (head < 12 ? pp->b_q_norm : pp->b_k_norm) + l16 * 8;
    float gn[8];
#pragma unroll
    for (int i = 0; i < 8; ++i) gn[i] = gsrc[i];
    float fr[8];
#pragma unroll
    for (int i = 0; i < 8; ++i) { const int fi = (l16 & 3) * 8 + i; fr[i] = exp2f(-(float)fi * (13.287712379549449f / 32.f)) * 0.15915494309189535f; }
    const bool colsec = (l16 >> 3) != 0, x1lane = (l16 & 4) == 0;
    for (int row = blockIdx.x * 2 + (wid >> 2); row < MTOK; row += gridDim.x * 2) {
        bf16_t* ptr = pp->z + (size_t)row * BIN + head * HD + l16 * 8;
        const u32x4 w = *(const u32x4*)ptr;
        float v[8] = {bf_lo(w.x), bf_hi(w.x), bf_lo(w.y), bf_hi(w.y), bf_lo(w.z), bf_hi(w.z), bf_lo(w.w), bf_hi(w.w)};
        float ss = 0.f;
#pragma unroll
        for (int i = 0; i < 8; ++i) ss += v[i] * v[i];
        ss += __shfl_xor(ss, 1); ss += __shfl_xor(ss, 2); ss += __shfl_xor(ss, 4); ss += __shfl_xor(ss, 8);
        const float rs = rsqrtf(ss * (1.f / HD) + EPS);
        const int tpos = row & (SEQ - 1);
        const float pos = (float)(colsec ? (tpos & 63) : (tpos >> 6));
        float o[8];
#pragma unroll
        for (int i = 0; i < 8; ++i) {
            const float y = v[i] * rs * gn[i];
            const float py = __shfl_xor(y, 4);
            float rev = pos * fr[i]; rev -= floorf(rev);
            const float sn = __builtin_amdgcn_sinf(rev), cs = __builtin_amdgcn_cosf(rev);
            o[i] = x1lane ? (y * cs - py * sn) : (y * cs + py * sn);
        }
        u32x4 r; r.x = cvt_pk_bf16(o[0], o[1]); r.y = cvt_pk_bf16(o[2], o[3]); r.z = cvt_pk_bf16(o[4], o[5]); r.w = cvt_pk_bf16(o[6], o[7]);
        *(u32x4*)ptr = r;
    }
}

__device__ __forceinline__ void final_phase(const int tid, CParams* pp) {
    const int lane = tid & 63, wid = tid >> 6;
    for (int row = blockIdx.x * 8 + wid; row < MTOK; row += gridDim.x * 8) {
        const bf16_t* hr = pp->hb2 + (size_t)row * DM; float* orow = pp->out + (size_t)row * DM;
        u32x4 w[4]; float ss = 0.f;
#pragma unroll
        for (int i = 0; i < 4; ++i) { w[i] = *(const u32x4*)(hr + (i * 64 + lane) * 8);
            const float a0 = bf_lo(w[i].x), a1 = bf_hi(w[i].x), a2 = bf_lo(w[i].y), a3 = bf_hi(w[i].y), a4 = bf_lo(w[i].z), a5 = bf_hi(w[i].z), a6 = bf_lo(w[i].w), a7 = bf_hi(w[i].w);
            ss += a0 * a0 + a1 * a1 + a2 * a2 + a3 * a3 + a4 * a4 + a5 * a5 + a6 * a6 + a7 * a7; }
        const float rs = rsqrtf(wave_sum(ss) * (1.f / DM) + EPS);
#pragma unroll
        for (int i = 0; i < 4; ++i) { const int c = (i * 64 + lane) * 8;
            const f32x4 g0 = *(const f32x4*)(pp->final_norm + c), g1 = *(const f32x4*)(pp->final_norm + c + 4);
            f32x4 o0, o1;
            o0[0] = bf_lo(w[i].x) * rs * g0[0]; o0[1] = bf_hi(w[i].x) * rs * g0[1]; o0[2] = bf_lo(w[i].y) * rs * g0[2]; o0[3] = bf_hi(w[i].y) * rs * g0[3];
            o1[0] = bf_lo(w[i].z) * rs * g1[0]; o1[1] = bf_hi(w[i].z) * rs * g1[1]; o1[2] = bf_lo(w[i].w) * rs * g1[2]; o1[3] = bf_hi(w[i].w) * rs * g1[3];
            *(f32x4*)(orow + c) = o0; *(f32x4*)(orow + c + 4) = o1; }
    }
}
__device__ __forceinline__ void attn_phase(const int tid, CParams* pp, int layer, unsigned char* shm) {
    const int wid = __builtin_amdgcn_readfirstlane(tid >> 6), lane = tid & 63, r32 = lane & 31, hi = lane >> 5;
    const int xcd = blockIdx.x & 7, nper = gridDim.x >> 3;
    const int ldz = layer ? BIN : AIN, qmoff = layer ? 2560 : 4608;
    LAS float* tb = (LAS float*)((LAS unsigned char*)shm + at::TB_OFF);
    for (int i = blockIdx.x >> 3; i < 64; i += nper) {
        __syncthreads();
        const bf16_t *Q, *Kp, *Vp; bf16_t* O; int ldq = ldz, ldk, NT, tlo = 0, cmpb = 0; bool na = false; const LAS float* tbl = tb;
        if (i >= 48) {
            const int midx = xcd * 16 + (i - 48), b = midx >> 5, hm = (midx >> 3) & 3, qb = midx & 7;
            const size_t q0 = (size_t)(b * SEQ + qb * 256);
            Q = pp->z + q0 * ldz + qmoff + hm * HD;
            Kp = pp->kvm + (size_t)layer * (MMEM * 1024) + (size_t)(b * NMEM) * 1024 + hm * HD; Vp = Kp + 512; ldk = 1024; NT = 4;
            O = pp->cat + q0 * DM + 1536 + hm * HD;
        } else if (layer == 0) {
            const int group = xcd + 8 * (i >> 3), b = group / 12, h = group % 12, qb = i & 7;
            int kr0 = 4 * qb - 4; kr0 = kr0 < 0 ? 0 : (kr0 > 24 ? 24 : kr0);
            NT = (qb == 0 || qb == 7) ? 8 : 12; na = true;
            for (int e = tid; e < at::TB_FLOATS; e += 512) { const int k = e - 64; tb[e] = (k >= 0 && k < 465) ? pp->a_rpb[h * 465 + k] * 11.313708498984761f : 0.f; }
            __syncthreads();
            const int rq = 4 * qb + (wid >> 1), c = (wid & 1) * 32 + r32;
            int r0w = rq - 4; r0w = r0w < 0 ? 0 : (r0w > 24 ? 24 : r0w);
            int c0 = c - 8; c0 = c0 < 0 ? 0 : (c0 > 48 ? 48 : c0);
            tlo = r0w - kr0; cmpb = 4 * hi - c0;
            tbl = tb + 64 + (kr0 - rq + 7) * 31 + 15 - c + 4 * hi;
            const size_t q0 = (size_t)(b * SEQ + qb * 256), k0 = (size_t)(b * SEQ + kr0 * 64);
            Q = pp->z + q0 * AIN + h * HD;
            Kp = pp->z + k0 * AIN + 1536 + h * HD; Vp = Kp + 1536; ldk = AIN;
            O = pp->cat + q0 * DM + h * HD;
        } else {
            const int group = xcd + 8 * (i / 24), b = group >> 2, kvh = group & 3, w = i % 24, hq = kvh * 3 + (w >> 3), qb = w & 7;
            const size_t q0 = (size_t)(b * SEQ + qb * 256), k0 = (size_t)(b * SEQ);
            Q = pp->z + q0 * BIN + hq * HD;
            Kp = pp->z + k0 * BIN + 1536 + kvh * HD; Vp = Kp + 512; ldk = BIN; NT = 32;
            O = pp->cat + q0 * DM + hq * HD;
        }
        at::attn_body(tid, na, Q, ldq, Kp, Vp, ldk, O, DM, NT, (char*)shm, tlo, cmpb, tbl);
    }
}

#define XB_TMO      128
#define XB_XCNT(j)  (256  + 64 * (j))
#define XB_XSUB(j)  (1280 + 64 * (j))
#define XB_XGEN(j)  (2304 + 64 * (j))
#define XB_TOP      3328
#define XB_TOPGEN   3392
#define XCD_BAR_WORDS 3456
#define XB_SPIN_CAP (1u << 18)
__device__ __forceinline__ unsigned xb_ld(unsigned* p)              { return __hip_atomic_load(p, __ATOMIC_RELAXED, __HIP_MEMORY_SCOPE_AGENT); }
__device__ __forceinline__ unsigned xb_add(unsigned* p, unsigned v) { return __hip_atomic_fetch_add(p, v, __ATOMIC_RELAXED, __HIP_MEMORY_SCOPE_AGENT); }
__device__ __forceinline__ unsigned xb_xcc_id() { return (unsigned)__builtin_amdgcn_s_getreg((3 << 11) | 20) & 0xFu; }
#define XB_SPIN(cond, bar) do { unsigned _sp = 0; while (cond) { __builtin_amdgcn_s_sleep(1); \
    if ((++_sp & 255u) == 0u) { if (xb_ld(&(bar)[XB_TMO])) break; if (_sp > XB_SPIN_CAP) { atomicAdd(&(bar)[XB_TMO], 1u); break; } } } } while (0)
struct XcdBarrier { unsigned* bar; unsigned x; volatile LAS unsigned* st; };
__device__ __forceinline__ XcdBarrier xcd_barrier_post(unsigned* bar, volatile LAS unsigned* st) {
    XcdBarrier b; b.bar = bar; b.x = xb_xcc_id(); b.st = st;
    if (threadIdx.x == 0) (void)xb_add(&bar[XB_XCNT(b.x)], 1u);
    return b;
}
__device__ __forceinline__ void xcd_barrier_complete(unsigned* bar, unsigned x, unsigned& nloc, unsigned& nx) {
    const unsigned G = gridDim.x * gridDim.y * gridDim.z;
    unsigned sum, cnt, mine, sp = 0u;
    for (;;) {
        sum = 0u; cnt = 0u; mine = 0u;
#pragma unroll
        for (unsigned j = 0; j < 16; ++j) { const unsigned c = xb_ld(&bar[XB_XCNT(j)]); sum += c; cnt += (c > 0u) ? 1u : 0u; mine = (j == x) ? c : mine; }
        if (sum == G) break;
        __builtin_amdgcn_s_sleep(1);
        if ((++sp & 255u) == 0u) { if (xb_ld(&bar[XB_TMO])) break; if (sp > XB_SPIN_CAP) { atomicAdd(&bar[XB_TMO], 1u); break; } }
    }
    nloc = mine > 0u ? mine : 1u; nx = cnt > 0u ? cnt : 1u;
}
__device__ __forceinline__ void xcd_barrier(const XcdBarrier& b) {
    asm volatile("s_waitcnt vmcnt(0)" ::: "memory");
    __syncthreads();
    if (threadIdx.x == 0) {
        unsigned* bar = b.bar;
        __builtin_amdgcn_s_waitcnt(0);
        unsigned nloc = b.st[0], nx = b.st[1];
        if (nloc == 0u) { xcd_barrier_complete(bar, b.x, nloc, nx); b.st[0] = nloc; b.st[1] = nx; }
        const unsigned old = xb_add(&bar[XB_XSUB(b.x)], 1u);
        const unsigned gen = old / nloc;
        if (old + 1u == (gen + 1u) * nloc) {
            __builtin_amdgcn_fence(__ATOMIC_RELEASE, "agent");
            asm volatile("s_waitcnt vmcnt(0)" ::: "memory");
            const unsigned og = xb_add(&bar[XB_TOP], 1u);
            const unsigned tg = og / nx;
            if (og + 1u == (tg + 1u) * nx) xb_add(&bar[XB_TOPGEN], 1u);
            else XB_SPIN(xb_ld(&bar[XB_TOPGEN]) == tg, bar);
            __builtin_amdgcn_fence(__ATOMIC_ACQUIRE, "agent");
            xb_add(&bar[XB_XGEN(b.x)], 1u);
            asm volatile("s_waitcnt vmcnt(0)" ::: "memory");
        } else {
            XB_SPIN(xb_ld(&bar[XB_XGEN(b.x)]) == gen, bar);
            __builtin_amdgcn_fence(__ATOMIC_ACQUIRE, "agent");
            asm volatile("s_waitcnt vmcnt(0)" ::: "memory");
        }
    }
    __syncthreads();
}

__global__ void __launch_bounds__(512) mega(Params p, int ph_lo, int ph_hi) {
    extern __shared__ __attribute__((aligned(16))) unsigned char shm[];
    cg::grid_group grid = cg::this_grid();
    volatile LAS unsigned* xst = (volatile LAS unsigned*)((LAS unsigned char*)shm + 131072);
    if (threadIdx.x == 0) { xst[0] = 0u; xst[1] = 0u; }
    __syncthreads();
    (void)xcd_barrier_post(((CParams*)__builtin_amdgcn_kernarg_segment_ptr())->bar, xst);
    for (int ph = ph_lo; ph < ph_hi; ++ph) {
        int tid = threadIdx.x; asm volatile("" : "+v"(tid));
        CParams* pp = (CParams*)__builtin_amdgcn_kernarg_segment_ptr(); asm volatile("" : "+s"(pp));
        if (ph == 0) prep_phase(tid, pp, shm);
        else if (ph == 2 || ph == 8) attn_phase(tid, pp, ph == 8, shm);
        else if (ph == 7) qknorm_rope_phase(tid, pp);
        else if (ph == 12) { if (gridDim.x != 256) final_phase(tid, pp); }
        else {
            pg8::Gemm g; pg8::Sched S; pg8::Epi E;
            const int layer = ph >= 6;
            E.pp = pp; E.ph = ph;
            g.A = pp->acomb; g.K = DM; g.cstepA = 0; g.cstepB = 0;
            int nN = 8;
            if (ph == 1) { g.Bt = pp->wt_in0; nN = 20; }
            else if (ph == 6) { g.A = pp->hb2; g.Bt = pp->wt_in1; nN = 12; }
            else if (ph == 3 || ph == 9) { g.A = pp->cat; g.Bt = pp->wt_o + (size_t)layer * DM * DM; }
            else if (ph == 4 || ph == 10) { g.Bt = pp->wt_up + (size_t)layer * DM * DFF; nN = 32; }
            else { g.A = pp->u; g.K = DFF; g.cstepA = (size_t)MTOK * DM * 2; g.cstepB = (size_t)DM * DM * 2; g.Bt = pp->wt_down + (size_t)layer * DM * DFF; }
            S.init(32, nN, (int)gridDim.x, (int)blockIdx.x);
            if (ph == 1) { S.xM0 = 32; S.xnM = 4; S.xN0 = 20; S.nx = 32; }
            pg8::gemm_phase(tid, (LAS unsigned char*)shm, g, S, E);
        }
        {
            const int G = (int)gridDim.x, c = (int)blockIdx.x;
            int m0 = 0, r0 = 0, n0 = 1, m1 = 0, r1 = 0, n1 = 1;
            if (G != 256) { if (ph == 0) { m0 = 0x3FF; r0 = c; n0 = G; } }
            else if (ph == 0) { m0 = 0x007; r0 = c; n0 = 256; }
            else if (ph == 1 && c >= 160) { m0 = 0x050; r0 = c - 160; n0 = 96; m1 = 0x100; r1 = c - 160; n1 = 224; }
            else if (ph == 2 && (c >> 3) >= 16) { const int r = ((c >> 3) - 16) * 8 + (c & 7); m0 = 0x008; r0 = r; n0 = 128; m1 = 0x100; r1 = 96 + r; n1 = 224; }
            else if (ph == 6 && c >= 128) { m0 = 0x020; r0 = c - 128; n0 = 128; }
            else if (ph == 8 && (c >> 3) >= 16) { m0 = 0x280; r0 = ((c >> 3) - 16) * 8 + (c & 7); n0 = 128; }
            if (m0 | m1) {
                __syncthreads();
#pragma unroll 1
                for (int it = 0; it < 2; ++it) { const int cm = it ? m1 : m0; if (cm) convert_jobs(tid, pp, shm, cm, it ? r1 : r0, it ? n1 : n0); }
            }
        }
        if (ph + 1 < ph_hi && !(ph == 11 && gridDim.x == 256)) {
            if (ph_lo != 0) grid.sync();
            else { CParams* q = (CParams*)__builtin_amdgcn_kernarg_segment_ptr(); asm volatile("" : "+s"(q));
                   XcdBarrier xb_; xb_.bar = q->bar; xb_.x = xb_xcc_id(); xb_.st = (volatile LAS unsigned*)((LAS unsigned char*)shm + 131072); xcd_barrier(xb_); }
        }
    }
}

extern "C" void kernel_launch(void* const* d_in, const int* in_sizes, int n_in, void* d_out, int out_size, void* d_ws, size_t ws_size, hipStream_t stream) {
    constexpr size_t MiB = 1ull << 20;
    constexpr size_t O_WIN0 = 0, O_WIN1 = O_WIN0 + 28 * MiB, O_WO = O_WIN1 + 12 * MiB, O_WUP = O_WO + 16 * MiB, O_WDN = O_WUP + 64 * MiB,
                     O_ACOMB = O_WDN + 64 * MiB, O_R = O_ACOMB + 36 * MiB, O_U = O_R + 112 * MiB, O_KVM = O_U + 128 * MiB, O_SSQ = O_KVM + 4 * MiB, O_HB2 = O_SSQ + 8 * MiB, O_END = O_HB2 + 32 * MiB;
    static int grid_blocks = 0;
    if (grid_blocks == 0) {
        const long long expect[15] = {(long long)MTOK * DM, (long long)MMEM * DM, DM, 2 * DM, 2 * DM, (long long)DM * AIN, 12 * 15 * 31, (long long)DM * BIN, HD, HD,
                                      2LL * DM * 1024, 2LL * DM * DM, 2LL * DM * DFF, 2LL * DFF * DM, DM};
        bool bad = n_in != 15;
        for (int i = 0; i < 15 && !bad; ++i) bad = (long long)in_sizes[i] != expect[i];
        if (bad || in_sizes[0] != MTOK * DM || out_size != MTOK * DM || ws_size < O_END) {
            fprintf(stderr, "kernel_launch: unexpected shapes (n_in %d, in0 %d, out %d, ws %zu; need ws >= %zu)\n", n_in, n_in > 0 ? in_sizes[0] : -1, out_size, ws_size, (size_t)O_END);
            grid_blocks = -1; return; }
        int dev = 0, cus = 0, per_cu = 0;
        hipGetDevice(&dev);
        hipDeviceGetAttribute(&cus, hipDeviceAttributeMultiprocessorCount, dev);
        if (hipFuncSetAttribute((const void*)mega, hipFuncAttributeMaxDynamicSharedMemorySize, LDS_BYTES) != hipSuccess) { fprintf(stderr, "kernel_launch: hipFuncSetAttribute failed\n"); grid_blocks = -1; return; }
        if (hipOccupancyMaxActiveBlocksPerMultiprocessor(&per_cu, (const void*)mega, 512, LDS_BYTES) != hipSuccess || per_cu < 1) { fprintf(stderr, "kernel_launch: occupancy query gave %d\n", per_cu); per_cu = 1; (void)hipGetLastError(); }
        grid_blocks = (cus * per_cu) & ~7;
        if (grid_blocks > 256) grid_blocks = 256;
    }
    if (grid_blocks < 0) return;
    Params hp{};
    hp.x = (const float*)d_in[0]; hp.mem = (const float*)d_in[1]; hp.mem_norm = (const float*)d_in[2]; hp.attn_norm = (const float*)d_in[3]; hp.mlp_norm = (const float*)d_in[4];
    hp.a_w_in = (const float*)d_in[5]; hp.a_rpb = (const float*)d_in[6]; hp.b_w_in = (const float*)d_in[7]; hp.b_q_norm = (const float*)d_in[8]; hp.b_k_norm = (const float*)d_in[9];
    hp.w_mem_kv = (const float*)d_in[10]; hp.w_o = (const float*)d_in[11]; hp.w_up = (const float*)d_in[12]; hp.w_down = (const float*)d_in[13]; hp.final_norm = (const float*)d_in[14];
    hp.out = (float*)d_out;
    char* ws = (char*)d_ws;
    hp.wt_in0 = (bf16_t*)(ws + O_WIN0); hp.wt_in1 = (bf16_t*)(ws + O_WIN1); hp.wt_o = (bf16_t*)(ws + O_WO); hp.wt_up = (bf16_t*)(ws + O_WUP); hp.wt_down = (bf16_t*)(ws + O_WDN);
    hp.acomb = (bf16_t*)(ws + O_ACOMB); hp.z = (bf16_t*)(ws + O_R); hp.cat = (bf16_t*)(ws + O_R + 80 * MiB); hp.u = (bf16_t*)(ws + O_U); hp.kvm = (bf16_t*)(ws + O_KVM);
    hp.ssq = (float*)(ws + O_SSQ); hp.hb2 = (bf16_t*)(ws + O_HB2); hp.bar = (unsigned*)(ws + O_SSQ + 7 * MiB);
    if (hipMemsetAsync(hp.bar, 0, (4096 + 32 * 64) * sizeof(unsigned), stream) != hipSuccess) { fprintf(stderr, "kernel_launch: hipMemsetAsync failed\n"); return; }
#if MK_ONE_LAUNCH
    int lo = 0, hi = NPHASE;
    void* args[] = {&hp, &lo, &hi};
    hipError_t e = hipLaunchCooperativeKernel((const void*)mega, dim3(grid_blocks), dim3(512), args, LDS_BYTES, stream);
    if (e != hipSuccess) fprintf(stderr, "kernel_launch: cooperative launch failed: %s (grid %d)\n", hipGetErrorString(e), grid_blocks);
#else
    for (int ph = 0; ph < NPHASE; ++ph) {
        hipLaunchKernelGGL(mega, dim3(grid_blocks), dim3(512), LDS_BYTES, stream, hp, ph, ph + 1);
    }
    const hipError_t le = hipPeekAtLastError();
    if (le != hipSuccess) fprintf(stderr, "kernel_launch: launch failed: %s\n", hipGetErrorName(le));
#endif
}
```

```cpp
#include <hip/hip_runtime.h>
#include <hip/hip_cooperative_groups.h>
#include <cstdio>
#include <cstdint>
namespace cg = cooperative_groups;

#ifndef MK_ONE_LAUNCH
#define MK_ONE_LAUNCH 1
#endif

#define LAS __attribute__((address_space(3)))
typedef unsigned short bf16_t;
typedef short bf16x8 __attribute__((ext_vector_type(8)));
typedef short s16x4 __attribute__((ext_vector_type(4)));
typedef float f32x4 __attribute__((ext_vector_type(4)));
typedef float f32x16 __attribute__((ext_vector_type(16)));
typedef unsigned u32x4 __attribute__((ext_vector_type(4)));

constexpr int DM = 2048, NB = 4, SEQ = 2048, MTOK = NB * SEQ, HD = 128, NMEM = 256, MMEM = NB * NMEM, DFF = 8192;
constexpr int AIN = 5120, BIN = 3072;
constexpr float EPS = 1e-6f;
constexpr int LDS_BYTES = 131072 + 16;
constexpr int NPHASE = 13;

struct Params {
    const float *x, *mem, *mem_norm, *attn_norm, *mlp_norm, *a_w_in, *a_rpb, *b_w_in, *b_q_norm, *b_k_norm, *w_mem_kv, *w_o, *w_up, *w_down, *final_norm;
    float* out;
    bf16_t *wt_in0, *wt_in1, *wt_o, *wt_up, *wt_down;
    bf16_t *acomb;
    bf16_t *z, *cat, *u, *kvm;
    bf16_t* hb2;
    unsigned* bar;
    float* ssq;
};

typedef const Params __attribute__((address_space(4))) CParams;

__device__ __forceinline__ unsigned cvt_pk_bf16(float lo, float hi) { unsigned r; asm volatile("v_cvt_pk_bf16_f32 %0, %1, %2" : "=v"(r) : "v"(lo), "v"(hi)); return r; }
__device__ __forceinline__ float bf_lo(unsigned w) { return __uint_as_float(w << 16); }
__device__ __forceinline__ float bf_hi(unsigned w) { return __uint_as_float(w & 0xffff0000u); }
__device__ __forceinline__ float wave_sum(float v) {
#pragma unroll
    for (int o = 32; o; o >>= 1) v += __shfl_xor(v, o);
    return v;
}

namespace pg8 {
constexpr int BM = 256, BK = 64, HALF = 128, HTB = HALF * BK * 2, STAGE_BYTES = 8 * HTB, NXCD = 8, WGM = 8;
__device__ __forceinline__ int lds_byte(int r, int c) { const int st = (r >> 4) * 2 + (c >> 5), rr = r & 15, cc = c & 31, ob = rr * 64 + cc * 2; return st * 1024 + (ob ^ (((ob >> 9) & 1) << 5)); }
__device__ __forceinline__ void stage_rc(int b, int& R, int& C) { const int st = b / 1024, sb = b % 1024, swz = sb ^ (((sb >> 9) & 1) << 5); R = (st >> 1) * 16 + swz / 64; C = (st & 1) * 32 + (swz % 64) / 2; }
__device__ __forceinline__ int perm32(int rho) { const int n = rho >> 4, i = rho & 15; return 8 * (i >> 2) + 4 * n + (i & 3); }

struct Unit { int pm, pn; };
struct Gemm { const bf16_t* A; const bf16_t* Bt; int K; size_t cstepA, cstepB; };

struct Sched {
    int nM, nN, nwg, G, c;
    int xM0, xnM, xN0, nx;
    __device__ void init(int nM_, int nN_, int G_, int c_) { nM = nM_; nN = nN_; nwg = nM * nN; G = G_; c = c_; xM0 = 0; xnM = 1; xN0 = 0; nx = 0; }
    __device__ bool next(int i, Unit& u) const {
        const int L = i * G + c;
        if (L >= nwg) { const int e = L - nwg; if (e >= nx) return false; u.pm = xM0 + e % xnM; u.pn = xN0 + e / xnM; return true; }
        int wgid = L; { const int q = nwg / NXCD, r = nwg % NXCD, xcd = wgid % NXCD, off = wgid / NXCD; wgid = (xcd < r ? xcd * (q + 1) : r * (q + 1) + (xcd - r) * q) + off; }
        const int nig = WGM * nN, gid = wgid / nig, fm = gid * WGM, gsz = (nM - fm) < WGM ? (nM - fm) : WGM;
        u.pm = fm + ((wgid % nig) % gsz); u.pn = (wgid % nig) / gsz; return true;
    }
};

struct Epi {
    CParams* pp; int ph;
    __device__ __forceinline__ void operator()(const f32x4 (&acc)[2][2][4][2], const Unit& u, int wr, int wc, int fr, int fq) const {
        CParams* q = pp; asm volatile("" : "+s"(q));
        const int layer = ph >= 6, mode = (ph == 1 || ph == 6) ? 0 : ((ph == 4 || ph == 10) ? 1 : 2);
        bf16_t* O = mode == 0 ? q->z : (mode == 1 ? q->u : ((ph == 5 || ph == 11) ? q->hb2 : q->acomb));
        const int ldc = ph == 1 ? AIN : (ph == 6 ? BIN : DM);
        const float* ssq_in = q->ssq + (size_t)(ph == 1 ? 0 : (ph == 6 ? 2 : (layer ? 3 : 1))) * MTOK * 32;
        const float* hin = q->x;
        const bf16_t* hbin = ph == 3 ? nullptr : (ph == 9 ? q->hb2 : q->acomb);
        float* ssq_out = q->ssq + (size_t)(ph == 3 ? 1 : (ph == 5 ? 2 : (ph == 9 ? 3 : 4))) * MTOK * 32;
        bf16_t* kvm = q->kvm;
        const int row0 = u.pm * BM + wr * 64 + fr, col0 = u.pn * BM + wc * 32 + 8 * fq;
        if (mode == 2) {
            const float* __restrict__ hx = hin; const bf16_t* __restrict__ hb_ = hbin; bf16_t* __restrict__ ob_ = O; float* __restrict__ sq_ = ssq_out;
#pragma unroll
            for (int ai = 0; ai < 2; ++ai)
#pragma unroll
                for (int m = 0; m < 4; ++m) {
                    const int row = row0 + ai * HALF + m * 16; float ss = 0.f;
                    const size_t off0 = (size_t)row * DM + col0;
                    f32x4 h[2][2];
                    if (hb_ == nullptr) {
#pragma unroll
                        for (int bj = 0; bj < 2; ++bj) { h[bj][0] = *(const f32x4*)(hx + off0 + bj * HALF); h[bj][1] = *(const f32x4*)(hx + off0 + bj * HALF + 4); }
                    } else {
#pragma unroll
                        for (int bj = 0; bj < 2; ++bj) { const u32x4 w = *(const u32x4*)(hb_ + off0 + bj * HALF);
                            h[bj][0] = (f32x4){bf_lo(w.x), bf_hi(w.x), bf_lo(w.y), bf_hi(w.y)}; h[bj][1] = (f32x4){bf_lo(w.z), bf_hi(w.z), bf_lo(w.w), bf_hi(w.w)}; }
                    }
#pragma unroll
                    for (int bj = 0; bj < 2; ++bj) {
                        const size_t off = off0 + bj * HALF;
                        const f32x4 v0 = acc[ai][bj][m][0] + h[bj][0], v1 = acc[ai][bj][m][1] + h[bj][1];
                        ss += v0[0] * v0[0] + v0[1] * v0[1] + v0[2] * v0[2] + v0[3] * v0[3] + v1[0] * v1[0] + v1[1] * v1[1] + v1[2] * v1[2] + v1[3] * v1[3];
                        u32x4 w; w.x = cvt_pk_bf16(v0[0], v0[1]); w.y = cvt_pk_bf16(v0[2], v0[3]); w.z = cvt_pk_bf16(v1[0], v1[1]); w.w = cvt_pk_bf16(v1[2], v1[3]);
                        *(u32x4*)(ob_ + off) = w;
                    }
                    ss += __shfl_xor(ss, 16); ss += __shfl_xor(ss, 32);
                    if (fq == 0) sq_[(size_t)row * 32 + u.pn * 4 + wc] = ss;
                }
        } else {
            const bool extra = u.pm >= 32;
            bf16_t* base = O; int ld = ldc, r0 = row0, c0 = col0;
            if (mode == 1) { const int ch = u.pn >> 3; base += (size_t)ch * ((size_t)MTOK * DM); c0 -= ch * DM; }
            if (extra) { const int j = (u.pn - 20) >> 2; base = kvm + (size_t)j * (MMEM * 1024); ld = 1024; r0 = row0 - MTOK; c0 = col0 - AIN - j * 1024; }
#pragma unroll
            for (int ai = 0; ai < 2; ++ai)
#pragma unroll
                for (int m = 0; m < 4; ++m) {
                    const int row = r0 + ai * HALF + m * 16;
                    float rs = 1.f;
                    if (!extra) { const f32x4 a = *(const f32x4*)(ssq_in + (size_t)row * 32 + fq * 8), b = *(const f32x4*)(ssq_in + (size_t)row * 32 + fq * 8 + 4);
                        float sq = (a[0] + a[1]) + (a[2] + a[3]) + (b[0] + b[1]) + (b[2] + b[3]);
                        sq += __shfl_xor(sq, 16); sq += __shfl_xor(sq, 32);
                        rs = rsqrtf(sq * (1.f / DM) + EPS); }
                    bf16_t* rowp = base + (size_t)row * ld + c0;
#pragma unroll
                    for (int bj = 0; bj < 2; ++bj) {
                        f32x4 v0 = acc[ai][bj][m][0] * rs, v1 = acc[ai][bj][m][1] * rs;
                        if (mode == 1) {
#pragma unroll
                            for (int j = 0; j < 4; ++j) { const float a = fmaxf(v0[j], 0.f), b = fmaxf(v1[j], 0.f); v0[j] = a * a; v1[j] = b * b; }
                        }
                        u32x4 w; w.x = cvt_pk_bf16(v0[0], v0[1]); w.y = cvt_pk_bf16(v0[2], v0[3]); w.z = cvt_pk_bf16(v1[0], v1[1]); w.w = cvt_pk_bf16(v1[2], v1[3]);
                        *(u32x4*)(rowp + bj * HALF) = w;
                    }
                }
        }
    }
};

__device__ __forceinline__ void gemm_phase(const int tid, LAS unsigned char* lds, const Gemm g, const Sched& S, const Epi& E) {
    const int wid = __builtin_amdgcn_readfirstlane(tid >> 6), lane = tid & 63, wr = wid >> 2, wc = wid & 3, fr = lane & 15, fq = lane >> 4;
    const int K = g.K, nt = K / BK;
    unsigned voffA[2], voffB[2];
#pragma unroll
    for (int i = 0; i < 2; ++i) { int R, C; stage_rc(tid * 16 + i * 8192, R, C); const int Rb = (R & ~31) + perm32(R & 31);
        voffA[i] = (unsigned)(R * DM + C) * 2u; voffB[i] = (unsigned)(Rb * DM + C) * 2u; }
    const size_t kstep = (size_t)(BK * 2);
    const size_t hstep = (size_t)HALF * DM * 2;
    const size_t cstepA = g.cstepA, cstepB = g.cstepB;
#define PG8_OFFA(t) ((size_t)((t) >> 5) * cstepA + (size_t)((t) & 31) * kstep)
#define PG8_OFFB(t) ((size_t)((t) >> 5) * cstepB + (size_t)((t) & 31) * kstep)
    const size_t tstep = 2 * hstep;
    const unsigned ldsw = (unsigned)wid * 1024u;
    const int aoff = lds_byte(wr * 64 + fr, fq * 8), boff = lds_byte(wc * 32 + fr, fq * 8);
#define PG8_SA(b, h) (((b) * 2 + (h)) * HTB)
#define PG8_SB(b, h) ((4 + (b) * 2 + (h)) * HTB)
#define PG8_STAGE(bufoff, gbase, voff) do { _Pragma("unroll") for (int _i = 0; _i < 2; ++_i) \
        __builtin_amdgcn_global_load_lds((const unsigned*)((const char*)(gbase) + (voff)[_i]), (LAS unsigned*)(lds + (bufoff) + ldsw + _i * 8192), 16, 0, 0); } while (0)
#define PG8_LDA(dst, b, h) do { _Pragma("unroll") for (int m = 0; m < 4; ++m) _Pragma("unroll") for (int k = 0; k < 2; ++k) dst[m][k] = *(const LAS bf16x8*)(lds + PG8_SA(b, h) + aoff + m * 2048 + k * 1024); } while (0)
#define PG8_LDB(dst, b, h) do { _Pragma("unroll") for (int n = 0; n < 2; ++n) _Pragma("unroll") for (int k = 0; k < 2; ++k) dst[n][k] = *(const LAS bf16x8*)(lds + PG8_SB(b, h) + boff + n * 2048 + k * 1024); } while (0)
#define PG8_MMA(ai, bj, At, Bt) do { __builtin_amdgcn_s_setprio(1); _Pragma("unroll") for (int m = 0; m < 4; ++m) _Pragma("unroll") for (int n = 0; n < 2; ++n) _Pragma("unroll") for (int k = 0; k < 2; ++k) \
        acc[ai][bj][m][n] = __builtin_amdgcn_mfma_f32_16x16x32_bf16(Bt[n][k], At[m][k], acc[ai][bj][m][n], 0, 0, 0); __builtin_amdgcn_s_setprio(0); } while (0)
#define PG8_WAIT_V(n) asm volatile("s_waitcnt vmcnt(" #n ")" ::: "memory")
#define PG8_WAIT_L(n) asm volatile("s_waitcnt lgkmcnt(" #n ")" ::: "memory")
#define PG8_BAR __builtin_amdgcn_s_barrier()
#define PG8_SCHED __builtin_amdgcn_sched_barrier(0)
    Unit cur, nxt; int ui = 0;
    if (!S.next(0, cur)) return;
    f32x4 acc[2][2][4][2];
#pragma unroll
    for (int a = 0; a < 2; ++a)
#pragma unroll
        for (int b = 0; b < 2; ++b)
#pragma unroll
            for (int m = 0; m < 4; ++m)
#pragma unroll
                for (int n = 0; n < 2; ++n) acc[a][b][m][n] = (f32x4){0.f, 0.f, 0.f, 0.f};
    bf16x8 At[4][2], B0[2][2], B1[2][2];
    const char* cA = (const char*)g.A + (size_t)cur.pm * tstep; const char* cB = (const char*)g.Bt + (size_t)cur.pn * tstep;
    PG8_STAGE(PG8_SB(0, 0), cB, voffB); PG8_STAGE(PG8_SA(0, 0), cA, voffA); PG8_STAGE(PG8_SB(0, 1), cB + hstep, voffB); PG8_STAGE(PG8_SA(0, 1), cA + hstep, voffA);
    if (wr == 1) PG8_BAR;
    PG8_WAIT_V(4); PG8_BAR;
    PG8_STAGE(PG8_SB(1, 0), cB + kstep, voffB); PG8_STAGE(PG8_SA(1, 0), cA + kstep, voffA); PG8_STAGE(PG8_SB(1, 1), cB + hstep + kstep, voffB);
    PG8_WAIT_V(6); PG8_BAR;
    for (;;) {
        const bool has_next = S.next(ui + 1, nxt);
        const char* nA = has_next ? (const char*)g.A + (size_t)nxt.pm * tstep : cA; const char* nB = has_next ? (const char*)g.Bt + (size_t)nxt.pn * tstep : cB;
        for (int t = 0; t < nt; t += 2) {
            const bool last = (t == nt - 2);
            const char* a1 = cA + PG8_OFFA(t + 1);
            const char* a2 = last ? nA : cA + PG8_OFFA(t + 2); const char* b2 = last ? nB : cB + PG8_OFFB(t + 2);
            const char* a3 = a2 + kstep; const char* b3 = b2 + kstep;
            PG8_LDB(B0, 0, 0); PG8_SCHED; PG8_LDA(At, 0, 0); PG8_STAGE(PG8_SA(1, 1), a1 + hstep, voffA);
            PG8_WAIT_L(8); PG8_BAR; PG8_WAIT_L(0); PG8_MMA(0, 0, At, B0); PG8_BAR; PG8_SCHED;
            PG8_LDB(B1, 0, 1); PG8_STAGE(PG8_SB(0, 0), b2, voffB);
            PG8_BAR; PG8_WAIT_L(0); PG8_MMA(0, 1, At, B1); PG8_BAR;
            PG8_LDA(At, 0, 1); PG8_STAGE(PG8_SA(0, 0), a2, voffA);
            PG8_BAR; PG8_WAIT_L(0); PG8_MMA(1, 0, At, B0); PG8_BAR; PG8_SCHED;
            PG8_STAGE(PG8_SB(0, 1), b2 + hstep, voffB);
            PG8_WAIT_V(6); PG8_BAR; PG8_MMA(1, 1, At, B1); PG8_BAR;
            PG8_LDB(B0, 1, 0); PG8_SCHED; PG8_LDA(At, 1, 0); PG8_STAGE(PG8_SA(0, 1), a2 + hstep, voffA);
            PG8_WAIT_L(8); PG8_BAR; PG8_WAIT_L(0); PG8_MMA(0, 0, At, B0); PG8_BAR; PG8_SCHED;
            PG8_LDB(B1, 1, 1); PG8_STAGE(PG8_SB(1, 0), b3, voffB);
            PG8_BAR; PG8_WAIT_L(0); PG8_MMA(0, 1, At, B1); PG8_BAR;
            PG8_LDA(At, 1, 1); PG8_STAGE(PG8_SA(1, 0), a3, voffA);
            PG8_BAR; PG8_WAIT_L(0); PG8_MMA(1, 0, At, B0); PG8_BAR; PG8_SCHED;
            PG8_STAGE(PG8_SB(1, 1), b3 + hstep, voffB);
            PG8_WAIT_V(6); PG8_BAR; PG8_MMA(1, 1, At, B1); PG8_BAR;
        }
        E(acc, cur, wr, wc, fr, fq);
        if (!has_next) break;
#pragma unroll
        for (int a = 0; a < 2; ++a)
#pragma unroll
            for (int b = 0; b < 2; ++b)
#pragma unroll
                for (int m = 0; m < 4; ++m)
#pragma unroll
                    for (int n = 0; n < 2; ++n) acc[a][b][m][n] = (f32x4){0.f, 0.f, 0.f, 0.f};
        cur = nxt; cA = nA; cB = nB; ++ui;
    }
    PG8_WAIT_V(0);
    if (wr == 0) PG8_BAR;
    PG8_BAR;
#undef PG8_OFFA
#undef PG8_OFFB
#undef PG8_SA
#undef PG8_SB
#undef PG8_STAGE
#undef PG8_LDA
#undef PG8_LDB
#undef PG8_MMA
#undef PG8_WAIT_V
#undef PG8_WAIT_L
#undef PG8_BAR
#undef PG8_SCHED
}
}

namespace at {
constexpr int D = 128, NW = 8, QBLK = 32, KVBLK = 64;
constexpr float SCALE = 0.088388347648318440f;
constexpr float THR = 8.f;
constexpr size_t SHM_V = KVBLK * D * 2, SHM_K = KVBLK * D * 2, SHM_ATTN = 3 * SHM_V + 3 * SHM_K + NW * 64 * 4;
constexpr int TB_OFF = (int)SHM_ATTN, TB_FLOATS = 640;
#define KSWZ(row, colB) ((row) * 256 + ((colB) ^ (((row) & 7) << 4)))
#define SBAR() __builtin_amdgcn_sched_barrier(0)
__device__ __forceinline__ int crow(int r, int hi) { return (r & 3) + 8 * (r >> 2) + 4 * hi; }

__device__ __forceinline__ void partialSM(f32x16& p0, f32x16& p1, float& m_reg, float& mn, float& alpha) {
    constexpr float C = SCALE * 1.4426950408889634f;
    float pmax = p0[0];
#pragma unroll
    for (int r = 1; r < 16; ++r) pmax = fmaxf(pmax, p0[r]);
#pragma unroll
    for (int r = 0; r < 16; ++r) pmax = fmaxf(pmax, p1[r]);
    { auto rr = __builtin_amdgcn_permlane32_swap(__float_as_uint(pmax), __float_as_uint(pmax), false, false);
      pmax = fmaxf(__uint_as_float(rr[0]), __uint_as_float(rr[1])); }
    if (__builtin_expect(__all(pmax - m_reg <= THR / SCALE), 1)) { mn = m_reg; alpha = 1.f; }
    else { mn = fmaxf(m_reg, pmax); alpha = __builtin_amdgcn_exp2f((m_reg - mn) * C); m_reg = mn; }
    const float mnC = -mn * C;
#pragma unroll
    for (int r = 0; r < 16; ++r) p0[r] = fmaf(p0[r], C, mnC);
#pragma unroll
    for (int r = 0; r < 16; ++r) p1[r] = fmaf(p1[r], C, mnC);
#pragma unroll
    for (int r = 0; r < 16; ++r) p0[r] = __builtin_amdgcn_exp2f(p0[r]);
}
__device__ __forceinline__ void finishSM(f32x16& p0, f32x16& p1, float alpha, float& l_reg, bf16x8& pa0, bf16x8& pa1, bf16x8& pa2, bf16x8& pa3) {
#pragma unroll
    for (int r = 0; r < 16; ++r) p1[r] = __builtin_amdgcn_exp2f(p1[r]);
    float ps = 0;
#pragma unroll
    for (int r = 0; r < 16; ++r) ps += p0[r];
#pragma unroll
    for (int r = 0; r < 16; ++r) ps += p1[r];
    { auto rr = __builtin_amdgcn_permlane32_swap(__float_as_uint(ps), __float_as_uint(ps), false, false);
      ps = __uint_as_float(rr[0]) + __uint_as_float(rr[1]); }
    l_reg = l_reg * alpha + ps;
#define PK4(P, BASE, OUT) do { unsigned a0 = cvt_pk_bf16(P[BASE + 0], P[BASE + 1]), a1 = cvt_pk_bf16(P[BASE + 2], P[BASE + 3]);   \
    unsigned b0 = cvt_pk_bf16(P[BASE + 4], P[BASE + 5]), b1 = cvt_pk_bf16(P[BASE + 6], P[BASE + 7]);                              \
    auto r0 = __builtin_amdgcn_permlane32_swap(a0, b0, false, false); auto r1 = __builtin_amdgcn_permlane32_swap(a1, b1, false, false); \
    u32x4 w = {r0[0], r1[0], r0[1], r1[1]}; OUT = *reinterpret_cast<bf16x8*>(&w); } while (0)
    PK4(p0, 0, pa0); PK4(p0, 8, pa1); PK4(p1, 0, pa2); PK4(p1, 8, pa3);
#undef PK4
}
__device__ __forceinline__ void qkt(f32x16& p0, f32x16& p1, const bf16_t* Ks, const bf16x8* qr, int r32, int hi) {
    p0 = f32x16{}; p1 = f32x16{};
#pragma unroll
    for (int d0 = 0; d0 < 8; ++d0) { const int cb = (d0 * 16 + hi * 8) * 2;
        bf16x8 b0 = *reinterpret_cast<const bf16x8*>((const char*)Ks + KSWZ(r32, cb));
        bf16x8 b1 = *reinterpret_cast<const bf16x8*>((const char*)Ks + KSWZ(32 + r32, cb));
        p0 = __builtin_amdgcn_mfma_f32_32x32x16_bf16(b0, qr[d0], p0, 0, 0, 0);
        p1 = __builtin_amdgcn_mfma_f32_32x32x16_bf16(b1, qr[d0], p1, 0, 0, 0); }
}
__device__ __forceinline__ int v_st(int k, int c) { const int kk = (k & ~0xC) | ((k & 4) << 1) | ((k & 8) >> 1); return ((kk >> 3) * 4 + (c >> 5)) * 512 + ((kk & 7) * 32 + (c & 31)) * 2; }
__device__ __forceinline__ int v_rd_base(int lane) { return ((lane & 3) << 3) | (((lane >> 2) & 3) << 6) | (((lane >> 4) & 1) << 5) | (((lane >> 5) & 1) << 8); }
constexpr int v_rd_off(int d0, int ks, int half) { return d0 * 512 + ks * 4096 + half * 2048; }
template <int OFF> __device__ __forceinline__ s16x4 tr_read(int vb) {
    s16x4 r; asm volatile("ds_read_b64_tr_b16 %0, %1 offset:%2" : "=&v"(r) : "v"(vb), "i"(OFF) : "memory"); return r;
}
template <int D0> __device__ __forceinline__ void pv_one(f32x16& od, int vb, bf16x8 pa0, bf16x8 pa1, bf16x8 pa2, bf16x8 pa3) {
    const s16x4 l0 = tr_read<v_rd_off(D0, 0, 0)>(vb), h0 = tr_read<v_rd_off(D0, 0, 1)>(vb), l1 = tr_read<v_rd_off(D0, 1, 0)>(vb), h1 = tr_read<v_rd_off(D0, 1, 1)>(vb);
    const s16x4 l2 = tr_read<v_rd_off(D0, 2, 0)>(vb), h2 = tr_read<v_rd_off(D0, 2, 1)>(vb), l3 = tr_read<v_rd_off(D0, 3, 0)>(vb), h3 = tr_read<v_rd_off(D0, 3, 1)>(vb);
    asm volatile("s_waitcnt lgkmcnt(0)" ::: "memory"); SBAR();
#define PK(L, H) (bf16x8){L[0], L[1], L[2], L[3], H[0], H[1], H[2], H[3]}
    od = __builtin_amdgcn_mfma_f32_32x32x16_bf16(pa0, PK(l0, h0), od, 0, 0, 0);
    od = __builtin_amdgcn_mfma_f32_32x32x16_bf16(pa1, PK(l1, h1), od, 0, 0, 0);
    od = __builtin_amdgcn_mfma_f32_32x32x16_bf16(pa2, PK(l2, h2), od, 0, 0, 0);
    od = __builtin_amdgcn_mfma_f32_32x32x16_bf16(pa3, PK(l3, h3), od, 0, 0, 0);
#undef PK
}
__device__ __forceinline__ void pv_d0(f32x16* o, int vb, bf16x8 pa0, bf16x8 pa1, bf16x8 pa2, bf16x8 pa3) {
    pv_one<0>(o[0], vb, pa0, pa1, pa2, pa3); pv_one<1>(o[1], vb, pa0, pa1, pa2, pa3); pv_one<2>(o[2], vb, pa0, pa1, pa2, pa3); pv_one<3>(o[3], vb, pa0, pa1, pa2, pa3);
}
__device__ __forceinline__ void na_hook(f32x16& p0, f32x16& p1, int j, int tlo, int cmpb, const LAS float* tbl) {
    const float NINF = -__builtin_inff();
    const int cb = ((unsigned)(j - tlo) < 8u) ? cmpb : 4096;
    const volatile LAS float* t = tbl + j * 31;
#pragma unroll
    for (int rg = 0; rg < 4; ++rg) {
#pragma unroll
        for (int rr = 0; rr < 4; ++rr) { const int r = rg * 4 + rr, kc = rr + 8 * rg;
            const float b0 = t[kc], b1 = t[kc + 32];
            p0[r] = ((unsigned)(kc + cb) < 16u) ? p0[r] + b0 : NINF;
            p1[r] = ((unsigned)(kc + 32 + cb) < 16u) ? p1[r] + b1 : NINF; }
        SBAR();
    }
}

__device__ __forceinline__ void attn_body(const int tid, const bool NA, const bf16_t* __restrict__ Qb, int ldq, const bf16_t* __restrict__ Kh, const bf16_t* __restrict__ Vh, int ldk,
                                          bf16_t* __restrict__ Ob, int ldo, int NT, char* lds, int tlo, int cmpb, const LAS float* tbl) {
    const int wid = __builtin_amdgcn_readfirstlane(tid >> 6), lane = tid & 63, r32 = lane & 31, hi = lane >> 5;
    bf16_t* V_lds = (bf16_t*)lds; bf16_t* K_lds = (bf16_t*)(lds + 3 * SHM_V);
    float* ws = (float*)(lds + 3 * SHM_V + 3 * SHM_K) + wid * 64; float* li_l = ws; float* al_l = ws + 32;
    float m_reg = -1e30f, l_reg = 0; f32x16 o[4] = {}; bf16x8 qr[8];
    const bf16_t* Qw = Qb + (size_t)(wid * QBLK + r32) * ldq + hi * 8;
#pragma unroll
    for (int d0 = 0; d0 < 8; ++d0) qr[d0] = *reinterpret_cast<const bf16x8*>(Qw + d0 * 16);
    const int sr = tid >> 4, sc = (tid & 15) * 8, vst0 = v_st(sr, sc), kst0 = KSWZ(sr, sc * 2);
    const int vb0 = (int)(uintptr_t)V_lds + v_rd_base(lane);
    constexpr int SDEPTH = 1;
    struct { bf16x8 vs0, vs1, ks0, ks1; } sr_[SDEPTH];
    const unsigned vo0 = (unsigned)(sr * ldk + sc) * 2u, vo1 = vo0 + (unsigned)(32 * ldk) * 2u;
    const char* Kc = (const char*)Kh; const char* Vc = (const char*)Vh; const size_t tile_b = (size_t)KVBLK * ldk * 2;
#define SLOAD(i, t) do { const char* kb_ = Kc + (size_t)(t) * tile_b; const char* vb_ = Vc + (size_t)(t) * tile_b; \
    sr_[i].vs0 = *reinterpret_cast<const bf16x8*>(vb_ + vo0); sr_[i].vs1 = *reinterpret_cast<const bf16x8*>(vb_ + vo1); \
    sr_[i].ks0 = *reinterpret_cast<const bf16x8*>(kb_ + vo0); sr_[i].ks1 = *reinterpret_cast<const bf16x8*>(kb_ + vo1); } while (0)
#define SWRITE(b, i) do { *(bf16x8*)((char*)V_lds + (b) * SHM_V + vst0) = sr_[i].vs0;          \
    *(bf16x8*)((char*)V_lds + (b) * SHM_V + vst0 + 8192) = sr_[i].vs1;                          \
    *(bf16x8*)((char*)K_lds + (b) * SHM_K + kst0) = sr_[i].ks0;                                \
    *(bf16x8*)((char*)K_lds + (b) * SHM_K + kst0 + 8192) = sr_[i].ks1; } while (0)
#define SWAIT() do { if constexpr (SDEPTH == 2) asm volatile("s_waitcnt vmcnt(4)" ::: "memory"); else asm volatile("s_waitcnt vmcnt(0)" ::: "memory"); } while (0)
#define RESC(a) do { if (__any((a) < 1.f)) { if (hi == 0) al_l[r32] = (a); asm volatile("s_waitcnt lgkmcnt(0)" ::: "memory"); \
    _Pragma("unroll") for (int d = 0; d < 4; ++d) _Pragma("unroll") for (int r = 0; r < 16; ++r) o[d][r] *= al_l[crow(r, hi)]; } } while (0)
#define HOOK(P0, P1, J) do { if (NA) na_hook(P0, P1, (J), tlo, cmpb, tbl); } while (0)
    f32x16 pA0, pA1, pB0, pB1; float mnA, mnB, alA, alB; bf16x8 pa0, pa1, pa2, pa3;
    constexpr int SE = 0, SO = SDEPTH - 1;
    SLOAD(SE, 0); asm volatile("s_waitcnt vmcnt(0)" ::: "memory"); SWRITE(0, SE); __syncthreads();
    qkt(pA0, pA1, K_lds, qr, r32, hi); HOOK(pA0, pA1, 0); partialSM(pA0, pA1, m_reg, mnA, alA);
    SLOAD(SO, 1); if constexpr (SDEPTH == 2) { if (2 < NT) SLOAD(SE, 2); }
    SWAIT(); SWRITE(1, SO); __syncthreads();
    int bp = 0, bc = 1, bn = 2;
#define ROT() do { const int t_ = bp; bp = bc; bc = bn; bn = t_; } while (0)
    for (int j = 1; j + 1 < NT; j += 2) {
        SBAR(); qkt(pB0, pB1, (bf16_t*)((char*)K_lds + bc * (int)SHM_K), qr, r32, hi); HOOK(pB0, pB1, j);
        finishSM(pA0, pA1, alA, l_reg, pa0, pa1, pa2, pa3); SBAR();
        SLOAD(SO, j + 1); SBAR();
        pv_d0(o, vb0 + bp * (int)SHM_V, pa0, pa1, pa2, pa3); partialSM(pB0, pB1, m_reg, mnB, alB);
        SWAIT(); SWRITE(bn, SE); RESC(alB); __syncthreads(); ROT();
        SBAR(); qkt(pA0, pA1, (bf16_t*)((char*)K_lds + bc * (int)SHM_K), qr, r32, hi); HOOK(pA0, pA1, j + 1);
        finishSM(pB0, pB1, alB, l_reg, pa0, pa1, pa2, pa3); SBAR();
        SLOAD(SE, j + 2); SBAR();
        pv_d0(o, vb0 + bp * (int)SHM_V, pa0, pa1, pa2, pa3); partialSM(pA0, pA1, m_reg, mnA, alA);
        SWAIT(); SWRITE(bn, SO); RESC(alA); __syncthreads(); ROT();
    }
    SBAR(); qkt(pB0, pB1, (bf16_t*)((char*)K_lds + bc * (int)SHM_K), qr, r32, hi); HOOK(pB0, pB1, NT - 1);
    finishSM(pA0, pA1, alA, l_reg, pa0, pa1, pa2, pa3); SBAR();
    pv_d0(o, vb0 + bp * (int)SHM_V, pa0, pa1, pa2, pa3); partialSM(pB0, pB1, m_reg, mnB, alB);
    RESC(alB);
    finishSM(pB0, pB1, alB, l_reg, pa0, pa1, pa2, pa3); SBAR();
    pv_d0(o, vb0 + bc * (int)SHM_V, pa0, pa1, pa2, pa3);
#undef ROT
    if (hi == 0) li_l[r32] = l_reg; asm volatile("s_waitcnt lgkmcnt(0)" ::: "memory");
    float rli[16];
#pragma unroll
    for (int r = 0; r < 16; ++r) rli[r] = __builtin_amdgcn_rcpf(li_l[crow(r, hi)]);
    bf16_t* Ow = Ob + (size_t)(wid * QBLK) * ldo;
#pragma unroll
    for (int r = 0; r < 16; ++r) { const int orow = crow(r, hi);
#pragma unroll
        for (int d0 = 0; d0 < 4; ++d0) Ow[(size_t)orow * ldo + d0 * 32 + r32] = (bf16_t)(cvt_pk_bf16(o[d0][r] * rli[r], 0.f) & 0xffffu); }
#undef SLOAD
#undef SWRITE
#undef SWAIT
#undef RESC
#undef HOOK
}
}

__device__ __forceinline__ void wt_tile(const float* __restrict__ W, int N, bf16_t* __restrict__ Bt, int ldb, const float* __restrict__ g, int tk, int tn, unsigned* s, const int tid) {
    const int kp = tid >> 5, n4 = (tid & 31) * 4;
    f32x4 a[4], b[4];
#pragma unroll
    for (int pass = 0; pass < 4; ++pass) {
        const int k = tk * 128 + (pass * 16 + kp) * 2;
        const float* src = W + (size_t)k * N + tn * 128 + n4;
        a[pass] = __builtin_nontemporal_load((const f32x4*)src); b[pass] = __builtin_nontemporal_load((const f32x4*)(src + N));
    }
#pragma unroll
    for (int pass = 0; pass < 4; ++pass) {
        const int kpp = pass * 16 + kp, k = tk * 128 + kpp * 2;
        const float g0 = g ? g[k] : 1.f, g1 = g ? g[k + 1] : 1.f;
        s[(n4 + 0) * 65 + kpp] = cvt_pk_bf16(a[pass][0] * g0, b[pass][0] * g1);
        s[(n4 + 1) * 65 + kpp] = cvt_pk_bf16(a[pass][1] * g0, b[pass][1] * g1);
        s[(n4 + 2) * 65 + kpp] = cvt_pk_bf16(a[pass][2] * g0, b[pass][2] * g1);
        s[(n4 + 3) * 65 + kpp] = cvt_pk_bf16(a[pass][3] * g0, b[pass][3] * g1);
    }
    __syncthreads();
    const int ks = tid & 15;
#pragma unroll
    for (int pass = 0; pass < 4; ++pass) {
        const int n = pass * 32 + (tid >> 4);
        u32x4 w; w.x = s[n * 65 + ks * 4 + 0]; w.y = s[n * 65 + ks * 4 + 1]; w.z = s[n * 65 + ks * 4 + 2]; w.w = s[n * 65 + ks * 4 + 3];
        *(u32x4*)(Bt + (size_t)(tn * 128 + n) * ldb + ks * 8) = w;
    }
    __syncthreads();
}

__device__ __forceinline__ void prep_phase(const int tid, CParams* pp, unsigned char* shm) {
    const int lane = tid & 63, wid = tid >> 6;
    const int gw = blockIdx.x * 8 + wid, nw = gridDim.x * 8;
    for (int row = gw; row < MTOK; row += nw) {
        const float* xr = pp->x + (size_t)row * DM; bf16_t* hr = pp->acomb + (size_t)row * DM; float s = 0.f;
#pragma unroll
        for (int i = 0; i < 4; ++i) { const int c = (i * 64 + lane) * 8;
            const f32x4 a = *(const f32x4*)(xr + c), b = *(const f32x4*)(xr + c + 4);
            s += a[0] * a[0] + a[1] * a[1] + a[2] * a[2] + a[3] * a[3] + b[0] * b[0] + b[1] * b[1] + b[2] * b[2] + b[3] * b[3];
            u32x4 w; w.x = cvt_pk_bf16(a[0], a[1]); w.y = cvt_pk_bf16(a[2], a[3]); w.z = cvt_pk_bf16(b[0], b[1]); w.w = cvt_pk_bf16(b[2], b[3]);
            *(u32x4*)(hr + c) = w; }
        s += __shfl_xor(s, 32);
        if (lane < 32) pp->ssq[(size_t)row * 32 + lane] = s;
    }
    for (int row = gw; row < MMEM; row += nw) {
        const float* xr = pp->mem + (size_t)row * DM; bf16_t* hr = pp->acomb + (size_t)(MTOK + row) * DM; float s = 0.f;
        f32x4 a[4], b[4];
#pragma unroll
        for (int i = 0; i < 4; ++i) { const int c = (i * 64 + lane) * 8; a[i] = *(const f32x4*)(xr + c); b[i] = *(const f32x4*)(xr + c + 4);
            s += a[i][0] * a[i][0] + a[i][1] * a[i][1] + a[i][2] * a[i][2] + a[i][3] * a[i][3] + b[i][0] * b[i][0] + b[i][1] * b[i][1] + b[i][2] * b[i][2] + b[i][3] * b[i][3]; }
        s = wave_sum(s);
        const float rs = rsqrtf(s * (1.f / DM) + EPS);
#pragma unroll
        for (int i = 0; i < 4; ++i) { const int c = (i * 64 + lane) * 8;
            const f32x4 ga = *(const f32x4*)(pp->mem_norm + c), gb = *(const f32x4*)(pp->mem_norm + c + 4);
            u32x4 w; w.x = cvt_pk_bf16(a[i][0] * rs * ga[0], a[i][1] * rs * ga[1]); w.y = cvt_pk_bf16(a[i][2] * rs * ga[2], a[i][3] * rs * ga[3]);
            w.z = cvt_pk_bf16(b[i][0] * rs * gb[0], b[i][1] * rs * gb[1]); w.w = cvt_pk_bf16(b[i][2] * rs * gb[2], b[i][3] * rs * gb[3]);
            *(u32x4*)(hr + c) = w; }
    }
}

__device__ __forceinline__ void convert_jobs(const int tid, CParams* pp, unsigned char* shm, const int mask, const int rank, const int nranks) {
    unsigned* s = (unsigned*)shm;
    int t = rank;
#pragma unroll 1
    for (int job = 0; job < 10; ++job) {
        if (!((mask >> job) & 1)) continue;
        const float* W; const float* g = nullptr; bf16_t* Bt; int K = DM, N;
        switch (job) {
            case 0: W = pp->a_w_in; N = AIN; Bt = pp->wt_in0; g = pp->attn_norm; break;
            case 1: W = pp->w_mem_kv; N = 1024; Bt = pp->wt_in0 + (size_t)AIN * DM; break;
            case 2: W = pp->w_mem_kv + (size_t)DM * 1024; N = 1024; Bt = pp->wt_in0 + (size_t)(AIN + 1024) * DM; break;
            case 3: W = pp->b_w_in; N = BIN; Bt = pp->wt_in1; g = pp->attn_norm + DM; break;
            case 4: W = pp->w_o; N = DM; Bt = pp->wt_o; break;
            case 5: W = pp->w_o + (size_t)DM * DM; N = DM; Bt = pp->wt_o + (size_t)DM * DM; break;
            case 6: W = pp->w_up; N = DFF; Bt = pp->wt_up; g = pp->mlp_norm; break;
            case 7: W = pp->w_up + (size_t)DM * DFF; N = DFF; Bt = pp->wt_up + (size_t)DM * DFF; g = pp->mlp_norm + DM; break;
            case 8: W = pp->w_down; K = DFF; N = DM; Bt = pp->wt_down; break;
            default: W = pp->w_down + (size_t)DFF * DM; K = DFF; N = DM; Bt = pp->wt_down + (size_t)DFF * DM; break;
        }
        const int ntn = N / 128, ntiles = (K / 128) * ntn;
        for (; t < ntiles; t += nranks) { const int tk = t / ntn, k0 = tk * 128;
            bf16_t* dst = (K == DFF) ? Bt + (size_t)(k0 >> 11) * ((size_t)DM * DM) + (k0 & (DM - 1)) : Bt + k0;
            wt_tile(W, N, dst, DM, g, tk, t % ntn, s, tid); }
        t -= ntiles;
    }
}

__device__ __forceinline__ void qknorm_rope_phase(const int tid, CParams* pp) {
    const int lane = tid & 63, wid = tid >> 6, l16 = lane & 15;
    const int head = (wid & 3) * 4 + (lane >> 4);
    const float* gsrc = (head < 12 ? pp->b_q_norm : pp->b_k_norm) + l16 * 8;
    float gn[8];
#pragma unroll
    for (int i = 0; i < 8; ++i) gn[i] = gsrc[i];
    float fr[8];
#pragma unroll
    for (int i = 0; i < 8; ++i) { const int fi = (l16 & 3) * 8 + i; fr[i] = exp2f(-(float)fi * (13.287712379549449f / 32.f)) * 0.15915494309189535f; }
    const bool colsec = (l16 >> 3) != 0, x1lane = (l16 & 4) == 0;
    for (int row = blockIdx.x * 2 + (wid >> 2); row < MTOK; row += gridDim.x * 2) {
        bf16_t* ptr = pp->z + (size_t)row * BIN + head * HD + l16 * 8;
        const u32x4 w = *(const u32x4*)ptr;
        float v[8] = {bf_lo(w.x), bf_hi(w.x), bf_lo(w.y), bf_hi(w.y), bf_lo(w.z), bf_hi(w.z), bf_lo(w.w), bf_hi(w.w)};
        float ss = 0.f;
#pragma unroll
        for (int i = 0; i < 8; ++i) ss += v[i] * v[i];
        ss += __shfl_xor(ss, 1); ss += __shfl_xor(ss, 2); ss += __shfl_xor(ss, 4); ss += __shfl_xor(ss, 8);
        const float rs = rsqrtf(ss * (1.f / HD) + EPS);
        const int tpos = row & (SEQ - 1);
        const float pos = (float)(colsec ? (tpos & 63) : (tpos >> 6));
        float o[8];
#pragma unroll
        for (int i = 0; i < 8; ++i) {
            const float y = v[i] * rs * gn[i];
            const float py = __shfl_xor(y, 4);
            float rev = pos * fr[i]; rev -= floorf(rev);
            const float sn = __builtin_amdgcn_sinf(rev), cs = __builtin_amdgcn_cosf(rev);
            o[i] = x1lane ? (y * cs - py * sn) : (y * cs + py * sn);
        }
        u32x4 r; r.x = cvt_pk_bf16(o[0], o[1]); r.y = cvt_pk_bf16(o[2], o[3]); r.z = cvt_pk_bf16(o[4], o[5]); r.w = cvt_pk_bf16(o[6], o[7]);
        *(u32x4*)ptr = r;
    }
}

__device__ __forceinline__ void final_phase(const int tid, CParams* pp) {
    const int lane = tid & 63, wid = tid >> 6;
    for (int row = blockIdx.x * 8 + wid; row < MTOK; row += gridDim.x * 8) {
        const bf16_t* hr = pp->hb2 + (size_t)row * DM; float* orow = pp->out + (size_t)row * DM;
        u32x4 w[4]; float ss = 0.f;
#pragma unroll
        for (int i = 0; i < 4; ++i) { w[i] = *(const u32x4*)(hr + (i * 64 + lane) * 8);
            const float a0 = bf_lo(w[i].x), a1 = bf_hi(w[i].x), a2 = bf_lo(w[i].y), a3 = bf_hi(w[i].y), a4 = bf_lo(w[i].z), a5 = bf_hi(w[i].z), a6 = bf_lo(w[i].w), a7 = bf_hi(w[i].w);
            ss += a0 * a0 + a1 * a1 + a2 * a2 + a3 * a3 + a4 * a4 + a5 * a5 + a6 * a6 + a7 * a7; }
        const float rs = rsqrtf(wave_sum(ss) * (1.f / DM) + EPS);
#pragma unroll
        for (int i = 0; i < 4; ++i) { const int c = (i * 64 + lane) * 8;
            const f32x4 g0 = *(const f32x4*)(pp->final_norm + c), g1 = *(const f32x4*)(pp->final_norm + c + 4);
            f32x4 o0, o1;
            o0[0] = bf_lo(w[i].x) * rs * g0[0]; o0[1] = bf_hi(w[i].x) * rs * g0[1]; o0[2] = bf_lo(w[i].y) * rs * g0[2]; o0[3] = bf_hi(w[i].y) * rs * g0[3];
            o1[0] = bf_lo(w[i].z) * rs * g1[0]; o1[1] = bf_hi(w[i].z) * rs * g1[1]; o1[2] = bf_lo(w[i].w) * rs * g1[2]; o1[3] = bf_hi(w[i].w) * rs * g1[3];
            *(f32x4*)(orow + c) = o0; *(f32x4*)(orow + c + 4) = o1; }
    }
}
__device__ __forceinline__ void attn_phase(const int tid, CParams* pp, int layer, unsigned char* shm) {
    const int wid = __builtin_amdgcn_readfirstlane(tid >> 6), lane = tid & 63, r32 = lane & 31, hi = lane >> 5;
    const int xcd = blockIdx.x & 7, nper = gridDim.x >> 3;
    const int ldz = layer ? BIN : AIN, qmoff = layer ? 2560 : 4608;
    LAS float* tb = (LAS float*)((LAS unsigned char*)shm + at::TB_OFF);
    for (int i = blockIdx.x >> 3; i < 64; i += nper) {
        __syncthreads();
        const bf16_t *Q, *Kp, *Vp; bf16_t* O; int ldq = ldz, ldk, NT, tlo = 0, cmpb = 0; bool na = false; const LAS float* tbl = tb;
        if (i >= 48) {
            const int midx = xcd * 16 + (i - 48), b = midx >> 5, hm = (midx >> 3) & 3, qb = midx & 7;
            const size_t q0 = (size_t)(b * SEQ + qb * 256);
            Q = pp->z + q0 * ldz + qmoff + hm * HD;
            Kp = pp->kvm + (size_t)layer * (MMEM * 1024) + (size_t)(b * NMEM) * 1024 + hm * HD; Vp = Kp + 512; ldk = 1024; NT = 4;
            O = pp->cat + q0 * DM + 1536 + hm * HD;
        } else if (layer == 0) {
            const int group = xcd + 8 * (i >> 3), b = group / 12, h = group % 12, qb = i & 7;
            int kr0 = 4 * qb - 4; kr0 = kr0 < 0 ? 0 : (kr0 > 24 ? 24 : kr0);
            NT = (qb == 0 || qb == 7) ? 8 : 12; na = true;
            for (int e = tid; e < at::TB_FLOATS; e += 512) { const int k = e - 64; tb[e] = (k >= 0 && k < 465) ? pp->a_rpb[h * 465 + k] * 11.313708498984761f : 0.f; }
            __syncthreads();
            const int rq = 4 * qb + (wid >> 1), c = (wid & 1) * 32 + r32;
            int r0w = rq - 4; r0w = r0w < 0 ? 0 : (r0w > 24 ? 24 : r0w);
            int c0 = c - 8; c0 = c0 < 0 ? 0 : (c0 > 48 ? 48 : c0);
            tlo = r0w - kr0; cmpb = 4 * hi - c0;
            tbl = tb + 64 + (kr0 - rq + 7) * 31 + 15 - c + 4 * hi;
            const size_t q0 = (size_t)(b * SEQ + qb * 256), k0 = (size_t)(b * SEQ + kr0 * 64);
            Q = pp->z + q0 * AIN + h * HD;
            Kp = pp->z + k0 * AIN + 1536 + h * HD; Vp = Kp + 1536; ldk = AIN;
            O = pp->cat + q0 * DM + h * HD;
        } else {
            const int group = xcd + 8 * (i / 24), b = group >> 2, kvh = group & 3, w = i % 24, hq = kvh * 3 + (w >> 3), qb = w & 7;
            const size_t q0 = (size_t)(b * SEQ + qb * 256), k0 = (size_t)(b * SEQ);
            Q = pp->z + q0 * BIN + hq * HD;
            Kp = pp->z + k0 * BIN + 1536 + kvh * HD; Vp = Kp + 512; ldk = BIN; NT = 32;
            O = pp->cat + q0 * DM + hq * HD;
        }
        at::attn_body(tid, na, Q, ldq, Kp, Vp, ldk, O, DM, NT, (char*)shm, tlo, cmpb, tbl);
    }
}

#define XB_TMO      128
#define XB_XCNT(j)  (256  + 64 * (j))
#define XB_XSUB(j)  (1280 + 64 * (j))
#define XB_XGEN(j)  (2304 + 64 * (j))
#define XB_TOP      3328
#define XB_TOPGEN   3392
#define XCD_BAR_WORDS 3456
#define XB_SPIN_CAP (1u << 18)
__device__ __forceinline__ unsigned xb_ld(unsigned* p)              { return __hip_atomic_load(p, __ATOMIC_RELAXED, __HIP_MEMORY_SCOPE_AGENT); }
__device__ __forceinline__ unsigned xb_add(unsigned* p, unsigned v) { return __hip_atomic_fetch_add(p, v, __ATOMIC_RELAXED, __HIP_MEMORY_SCOPE_AGENT); }
__device__ __forceinline__ unsigned xb_xcc_id() { return (unsigned)__builtin_amdgcn_s_getreg((3 << 11) | 20) & 0xFu; }
#define XB_SPIN(cond, bar) do { unsigned _sp = 0; while (cond) { __builtin_amdgcn_s_sleep(1); \
    if ((++_sp & 255u) == 0u) { if (xb_ld(&(bar)[XB_TMO])) break; if (_sp > XB_SPIN_CAP) { atomicAdd(&(bar)[XB_TMO], 1u); break; } } } } while (0)
struct XcdBarrier { unsigned* bar; unsigned x; volatile LAS unsigned* st; };
__device__ __forceinline__ XcdBarrier xcd_barrier_post(unsigned* bar, volatile LAS unsigned* st) {
    XcdBarrier b; b.bar = bar; b.x = xb_xcc_id(); b.st = st;
    if (threadIdx.x == 0) (void)xb_add(&bar[XB_XCNT(b.x)], 1u);
    return b;
}
__device__ __forceinline__ void xcd_barrier_complete(unsigned* bar, unsigned x, unsigned& nloc, unsigned& nx) {
    const unsigned G = gridDim.x * gridDim.y * gridDim.z;
    unsigned sum, cnt, mine, sp = 0u;
    for (;;) {
        sum = 0u; cnt = 0u; mine = 0u;
#pragma unroll
        for (unsigned j = 0; j < 16; ++j) { const unsigned c = xb_ld(&bar[XB_XCNT(j)]); sum += c; cnt += (c > 0u) ? 1u : 0u; mine = (j == x) ? c : mine; }
        if (sum == G) break;
        __builtin_amdgcn_s_sleep(1);
        if ((++sp & 255u) == 0u) { if (xb_ld(&bar[XB_TMO])) break; if (sp > XB_SPIN_CAP) { atomicAdd(&bar[XB_TMO], 1u); break; } }
    }
    nloc = mine > 0u ? mine : 1u; nx = cnt > 0u ? cnt : 1u;
}
__device__ __forceinline__ void xcd_barrier(const XcdBarrier& b) {
    asm volatile("s_waitcnt vmcnt(0)" ::: "memory");
    __syncthreads();
    if (threadIdx.x == 0) {
        unsigned* bar = b.bar;
        __builtin_amdgcn_s_waitcnt(0);
        unsigned nloc = b.st[0], nx = b.st[1];
        if (nloc == 0u) { xcd_barrier_complete(bar, b.x, nloc, nx); b.st[0] = nloc; b.st[1] = nx; }
        const unsigned old = xb_add(&bar[XB_XSUB(b.x)], 1u);
        const unsigned gen = old / nloc;
        if (old + 1u == (gen + 1u) * nloc) {
            __builtin_amdgcn_fence(__ATOMIC_RELEASE, "agent");
            asm volatile("s_waitcnt vmcnt(0)" ::: "memory");
            const unsigned og = xb_add(&bar[XB_TOP], 1u);
            const unsigned tg = og / nx;
            if (og + 1u == (tg + 1u) * nx) xb_add(&bar[XB_TOPGEN], 1u);
            else XB_SPIN(xb_ld(&bar[XB_TOPGEN]) == tg, bar);
            __builtin_amdgcn_fence(__ATOMIC_ACQUIRE, "agent");
            xb_add(&bar[XB_XGEN(b.x)], 1u);
            asm volatile("s_waitcnt vmcnt(0)" ::: "memory");
        } else {
            XB_SPIN(xb_ld(&bar[XB_XGEN(b.x)]) == gen, bar);
            __builtin_amdgcn_fence(__ATOMIC_ACQUIRE, "agent");
            asm volatile("s_waitcnt vmcnt(0)" ::: "memory");
        }
    }
    __syncthreads();
}

__global__ void __launch_bounds__(512) mega(Params p, int ph_lo, int ph_hi) {
    extern __shared__ __attribute__((aligned(16))) unsigned char shm[];
    cg::grid_group grid = cg::this_grid();
    volatile LAS unsigned* xst = (volatile LAS unsigned*)((LAS unsigned char*)shm + 131072);
    if (threadIdx.x == 0) { xst[0] = 0u; xst[1] = 0u; }
    __syncthreads();
    (void)xcd_barrier_post(((CParams*)__builtin_amdgcn_kernarg_segment_ptr())->bar, xst);
    for (int ph = ph_lo; ph < ph_hi; ++ph) {
        int tid = threadIdx.x; asm volatile("" : "+v"(tid));
        CParams* pp = (CParams*)__builtin_amdgcn_kernarg_segment_ptr(); asm volatile("" : "+s"(pp));
        if (ph == 0) prep_phase(tid, pp, shm);
        else if (ph == 2 || ph == 8) attn_phase(tid, pp, ph == 8, shm);
        else if (ph == 7) qknorm_rope_phase(tid, pp);
        else if (ph == 12) final_phase(tid, pp);
        else {
            pg8::Gemm g; pg8::Sched S; pg8::Epi E;
            const int layer = ph >= 6;
            E.pp = pp; E.ph = ph;
            g.A = pp->acomb; g.K = DM; g.cstepA = 0; g.cstepB = 0;
            int nN = 8;
            if (ph == 1) { g.Bt = pp->wt_in0; nN = 20; }
            else if (ph == 6) { g.A = pp->hb2; g.Bt = pp->wt_in1; nN = 12; }
            else if (ph == 3 || ph == 9) { g.A = pp->cat; g.Bt = pp->wt_o + (size_t)layer * DM * DM; }
            else if (ph == 4 || ph == 10) { g.Bt = pp->wt_up + (size_t)layer * DM * DFF; nN = 32; }
            else { g.A = pp->u; g.K = DFF; g.cstepA = (size_t)MTOK * DM * 2; g.cstepB = (size_t)DM * DM * 2; g.Bt = pp->wt_down + (size_t)layer * DM * DFF; }
            S.init(32, nN, (int)gridDim.x, (int)blockIdx.x);
            if (ph == 1) { S.xM0 = 32; S.xnM = 4; S.xN0 = 20; S.nx = 32; }
            pg8::gemm_phase(tid, (LAS unsigned char*)shm, g, S, E);
        }
        {
            const int G = (int)gridDim.x, c = (int)blockIdx.x;
            int m0 = 0, r0 = 0, n0 = 1, m1 = 0, r1 = 0, n1 = 1;
            if (G != 256) { if (ph == 0) { m0 = 0x3FF; r0 = c; n0 = G; } }
            else if (ph == 0) { m0 = 0x007; r0 = c; n0 = 256; }
            else if (ph == 1 && c >= 160) { m0 = 0x050; r0 = c - 160; n0 = 96; m1 = 0x100; r1 = c - 160; n1 = 224; }
            else if (ph == 2 && (c >> 3) >= 16) { const int r = ((c >> 3) - 16) * 8 + (c & 7); m0 = 0x008; r0 = r; n0 = 128; m1 = 0x100; r1 = 96 + r; n1 = 224; }
            else if (ph == 6 && c >= 128) { m0 = 0x020; r0 = c - 128; n0 = 128; }
            else if (ph == 8 && (c >> 3) >= 16) { m0 = 0x280; r0 = ((c >> 3) - 16) * 8 + (c & 7); n0 = 128; }
            if (m0 | m1) {
                __syncthreads();
#pragma unroll 1
                for (int it = 0; it < 2; ++it) { const int cm = it ? m1 : m0; if (cm) convert_jobs(tid, pp, shm, cm, it ? r1 : r0, it ? n1 : n0); }
            }
        }
        if (ph + 1 < ph_hi) {
            if (ph_lo != 0) grid.sync();
            else { CParams* q = (CParams*)__builtin_amdgcn_kernarg_segment_ptr(); asm volatile("" : "+s"(q));
                   XcdBarrier xb_; xb_.bar = q->bar; xb_.x = xb_xcc_id(); xb_.st = (volatile LAS unsigned*)((LAS unsigned char*)shm + 131072); xcd_barrier(xb_); }
        }
    }
}

extern "C" void kernel_launch(void* const* d_in, const int* in_sizes, int n_in, void* d_out, int out_size, void* d_ws, size_t ws_size, hipStream_t stream) {
    constexpr size_t MiB = 1ull << 20;
    constexpr size_t O_WIN0 = 0, O_WIN1 = O_WIN0 + 28 * MiB, O_WO = O_WIN1 + 12 * MiB, O_WUP = O_WO + 16 * MiB, O_WDN = O_WUP + 64 * MiB,
                     O_ACOMB = O_WDN + 64 * MiB, O_R = O_ACOMB + 36 * MiB, O_U = O_R + 112 * MiB, O_KVM = O_U + 128 * MiB, O_SSQ = O_KVM + 4 * MiB, O_HB2 = O_SSQ + 8 * MiB, O_END = O_HB2 + 32 * MiB;
    static int grid_blocks = 0;
    if (grid_blocks == 0) {
        const long long expect[15] = {(long long)MTOK * DM, (long long)MMEM * DM, DM, 2 * DM, 2 * DM, (long long)DM * AIN, 12 * 15 * 31, (long long)DM * BIN, HD, HD,
                                      2LL * DM * 1024, 2LL * DM * DM, 2LL * DM * DFF, 2LL * DFF * DM, DM};
        bool bad = n_in != 15;
        for (int i = 0; i < 15 && !bad; ++i) bad = (long long)in_sizes[i] != expect[i];
        if (bad || in_sizes[0] != MTOK * DM || out_size != MTOK * DM || ws_size < O_END) {
            fprintf(stderr, "kernel_launch: unexpected shapes (n_in %d, in0 %d, out %d, ws %zu; need ws >= %zu)\n", n_in, n_in > 0 ? in_sizes[0] : -1, out_size, ws_size, (size_t)O_END);
            grid_blocks = -1; return; }
        int dev = 0, cus = 0, per_cu = 0;
        hipGetDevice(&dev);
        hipDeviceGetAttribute(&cus, hipDeviceAttributeMultiprocessorCount, dev);
        if (hipFuncSetAttribute((const void*)mega, hipFuncAttributeMaxDynamicSharedMemorySize, LDS_BYTES) != hipSuccess) { fprintf(stderr, "kernel_launch: hipFuncSetAttribute failed\n"); grid_blocks = -1; return; }
        if (hipOccupancyMaxActiveBlocksPerMultiprocessor(&per_cu, (const void*)mega, 512, LDS_BYTES) != hipSuccess || per_cu < 1) { fprintf(stderr, "kernel_launch: occupancy query gave %d\n", per_cu); per_cu = 1; (void)hipGetLastError(); }
        grid_blocks = (cus * per_cu) & ~7;
        if (grid_blocks > 256) grid_blocks = 256;
    }
    if (grid_blocks < 0) return;
    Params hp{};
    hp.x = (const float*)d_in[0]; hp.mem = (const float*)d_in[1]; hp.mem_norm = (const float*)d_in[2]; hp.attn_norm = (const float*)d_in[3]; hp.mlp_norm = (const float*)d_in[4];
    hp.a_w_in = (const float*)d_in[5]; hp.a_rpb = (const float*)d_in[6]; hp.b_w_in = (const float*)d_in[7]; hp.b_q_norm = (const float*)d_in[8]; hp.b_k_norm = (const float*)d_in[9];
    hp.w_mem_kv = (const float*)d_in[10]; hp.w_o = (const float*)d_in[11]; hp.w_up = (const float*)d_in[12]; hp.w_down = (const float*)d_in[13]; hp.final_norm = (const float*)d_in[14];
    hp.out = (float*)d_out;
    char* ws = (char*)d_ws;
    hp.wt_in0 = (bf16_t*)(ws + O_WIN0); hp.wt_in1 = (bf16_t*)(ws + O_WIN1); hp.wt_o = (bf16_t*)(ws + O_WO); hp.wt_up = (bf16_t*)(ws + O_WUP); hp.wt_down = (bf16_t*)(ws + O_WDN);
    hp.acomb = (bf16_t*)(ws + O_ACOMB); hp.z = (bf16_t*)(ws + O_R); hp.cat = (bf16_t*)(ws + O_R + 80 * MiB); hp.u = (bf16_t*)(ws + O_U); hp.kvm = (bf16_t*)(ws + O_KVM);
    hp.ssq = (float*)(ws + O_SSQ); hp.hb2 = (bf16_t*)(ws + O_HB2); hp.bar = (unsigned*)(ws + O_SSQ + 7 * MiB);
    if (hipMemsetAsync(hp.bar, 0, XCD_BAR_WORDS * sizeof(unsigned), stream) != hipSuccess) { fprintf(stderr, "kernel_launch: hipMemsetAsync failed\n"); return; }
#if MK_ONE_LAUNCH
    int lo = 0, hi = NPHASE;
    void* args[] = {&hp, &lo, &hi};
    hipError_t e = hipLaunchCooperativeKernel((const void*)mega, dim3(grid_blocks), dim3(512), args, LDS_BYTES, stream);
    if (e != hipSuccess) fprintf(stderr, "kernel_launch: cooperative launch failed: %s (grid %d)\n", hipGetErrorString(e), grid_blocks);
#else
    for (int ph = 0; ph < NPHASE; ++ph) {
        hipLaunchKernelGGL(mega, dim3(grid_blocks), dim3(512), LDS_BYTES, stream, hp, ph, ph + 1);
    }
    const hipError_t le = hipPeekAtLastError();
    if (le != hipSuccess) fprintf(stderr, "kernel_launch: launch failed: %s\n", hipGetErrorName(le));
#endif
}
```

```cpp
#include <hip/hip_runtime.h>
#include <hip/hip_cooperative_groups.h>
#include <cstdio>
#include <cstdint>
namespace cg = cooperative_groups;

#ifndef MK_ONE_LAUNCH
#define MK_ONE_LAUNCH 1
#endif

#define LAS __attribute__((address_space(3)))
typedef unsigned short bf16_t;
typedef short bf16x8 __attribute__((ext_vector_type(8)));
typedef short s16x4 __attribute__((ext_vector_type(4)));
typedef float f32x4 __attribute__((ext_vector_type(4)));
typedef float f32x16 __attribute__((ext_vector_type(16)));
typedef unsigned u32x4 __attribute__((ext_vector_type(4)));

constexpr int DM = 2048, NB = 4, SEQ = 2048, MTOK = NB * SEQ, HD = 128, NMEM = 256, MMEM = NB * NMEM, DFF = 8192;
constexpr int AIN = 5120, BIN = 3072;
constexpr float EPS = 1e-6f;
constexpr int LDS_BYTES = 131072 + 16 + 1024;
constexpr int RS_OFF = 131072 + 16;
constexpr int NPHASE = 13;

struct Params {
    const float *x, *mem, *mem_norm, *attn_norm, *mlp_norm, *a_w_in, *a_rpb, *b_w_in, *b_q_norm, *b_k_norm, *w_mem_kv, *w_o, *w_up, *w_down, *final_norm;
    float* out;
    bf16_t *wt_in0, *wt_in1, *wt_o, *wt_up, *wt_down;
    bf16_t *acomb;
    bf16_t *z, *cat, *u, *kvm;
    bf16_t* hb2;
    unsigned* bar;
    float* ssq;
};

typedef const Params __attribute__((address_space(4))) CParams;

__device__ __forceinline__ unsigned cvt_pk_bf16(float lo, float hi) { unsigned r; asm volatile("v_cvt_pk_bf16_f32 %0, %1, %2" : "=v"(r) : "v"(lo), "v"(hi)); return r; }
__device__ __forceinline__ float bf_lo(unsigned w) { return __uint_as_float(w << 16); }
__device__ __forceinline__ float bf_hi(unsigned w) { return __uint_as_float(w & 0xffff0000u); }
__device__ __forceinline__ float wave_sum(float v) {
#pragma unroll
    for (int o = 32; o; o >>= 1) v += __shfl_xor(v, o);
    return v;
}

namespace pg8 {
constexpr int BM = 256, BK = 64, HALF = 128, HTB = HALF * BK * 2, STAGE_BYTES = 8 * HTB, NXCD = 8, WGM = 8;
__device__ __forceinline__ int lds_byte(int r, int c) { const int st = (r >> 4) * 2 + (c >> 5), rr = r & 15, cc = c & 31, ob = rr * 64 + cc * 2; return st * 1024 + (ob ^ (((ob >> 9) & 1) << 5)); }
__device__ __forceinline__ void stage_rc(int b, int& R, int& C) { const int st = b / 1024, sb = b % 1024, swz = sb ^ (((sb >> 9) & 1) << 5); R = (st >> 1) * 16 + swz / 64; C = (st & 1) * 32 + (swz % 64) / 2; }
__device__ __forceinline__ int perm32(int rho) { const int n = rho >> 4, i = rho & 15; return 8 * (i >> 2) + 4 * n + (i & 3); }

struct Unit { int pm, pn; };
struct Gemm { const bf16_t* A; const bf16_t* Bt; int K; size_t cstepA, cstepB; };

struct Sched {
    int nM, nN, nwg, G, c;
    int xM0, xnM, xN0, nx;
    __device__ void init(int nM_, int nN_, int G_, int c_) { nM = nM_; nN = nN_; nwg = nM * nN; G = G_; c = c_; xM0 = 0; xnM = 1; xN0 = 0; nx = 0; }
    __device__ bool next(int i, Unit& u) const {
        const int L = i * G + c;
        if (L >= nwg) { const int e = L - nwg; if (e >= nx) return false; u.pm = xM0 + e % xnM; u.pn = xN0 + e / xnM; return true; }
        int wgid = L; { const int q = nwg / NXCD, r = nwg % NXCD, xcd = wgid % NXCD, off = wgid / NXCD; wgid = (xcd < r ? xcd * (q + 1) : r * (q + 1) + (xcd - r) * q) + off; }
        const int nig = WGM * nN, gid = wgid / nig, fm = gid * WGM, gsz = (nM - fm) < WGM ? (nM - fm) : WGM;
        u.pm = fm + ((wgid % nig) % gsz); u.pn = (wgid % nig) / gsz; return true;
    }
};

struct Epi {
    int pm_tab;
    CParams* pp; int ph;
    __device__ __forceinline__ void operator()(const f32x4 (&acc)[2][2][4][2], const Unit& u, int wr, int wc, int fr, int fq) const {
        CParams* q = pp; asm volatile("" : "+s"(q));
        const int layer = ph >= 6, mode = (ph == 1 || ph == 6) ? 0 : ((ph == 4 || ph == 10) ? 1 : 2);
        bf16_t* O = mode == 0 ? q->z : (mode == 1 ? q->u : ((ph == 5 || ph == 11) ? q->hb2 : q->acomb));
        const int ldc = ph == 1 ? AIN : (ph == 6 ? BIN : DM);
        const float* ssq_in = q->ssq + (size_t)(ph == 1 ? 0 : (ph == 6 ? 2 : (layer ? 3 : 1))) * MTOK * 32;
        const float* hin = q->x;
        const bf16_t* hbin = ph == 3 ? nullptr : (ph == 9 ? q->hb2 : q->acomb);
        float* ssq_out = q->ssq + (size_t)(ph == 3 ? 1 : (ph == 5 ? 2 : (ph == 9 ? 3 : 4))) * MTOK * 32;
        bf16_t* kvm = q->kvm;
        const int row0 = u.pm * BM + wr * 64 + fr, col0 = u.pn * BM + wc * 32 + 8 * fq;
        if (mode == 2) {
            const float* __restrict__ hx = hin; const bf16_t* __restrict__ hb_ = hbin; bf16_t* __restrict__ ob_ = O; float* __restrict__ sq_ = ssq_out;
#pragma unroll
            for (int ai = 0; ai < 2; ++ai)
#pragma unroll
                for (int m = 0; m < 4; ++m) {
                    const int row = row0 + ai * HALF + m * 16; float ss = 0.f;
                    const size_t off0 = (size_t)row * DM + col0;
                    f32x4 h[2][2];
                    if (hb_ == nullptr) {
#pragma unroll
                        for (int bj = 0; bj < 2; ++bj) { h[bj][0] = *(const f32x4*)(hx + off0 + bj * HALF); h[bj][1] = *(const f32x4*)(hx + off0 + bj * HALF + 4); }
                    } else {
#pragma unroll
                        for (int bj = 0; bj < 2; ++bj) { const u32x4 w = *(const u32x4*)(hb_ + off0 + bj * HALF);
                            h[bj][0] = (f32x4){bf_lo(w.x), bf_hi(w.x), bf_lo(w.y), bf_hi(w.y)}; h[bj][1] = (f32x4){bf_lo(w.z), bf_hi(w.z), bf_lo(w.w), bf_hi(w.w)}; }
                    }
#pragma unroll
                    for (int bj = 0; bj < 2; ++bj) {
                        const size_t off = off0 + bj * HALF;
                        const f32x4 v0 = acc[ai][bj][m][0] + h[bj][0], v1 = acc[ai][bj][m][1] + h[bj][1];
                        ss += v0[0] * v0[0] + v0[1] * v0[1] + v0[2] * v0[2] + v0[3] * v0[3] + v1[0] * v1[0] + v1[1] * v1[1] + v1[2] * v1[2] + v1[3] * v1[3];
                        u32x4 w; w.x = cvt_pk_bf16(v0[0], v0[1]); w.y = cvt_pk_bf16(v0[2], v0[3]); w.z = cvt_pk_bf16(v1[0], v1[1]); w.w = cvt_pk_bf16(v1[2], v1[3]);
                        *(u32x4*)(ob_ + off) = w;
                    }
                    ss += __shfl_xor(ss, 16); ss += __shfl_xor(ss, 32);
                    if (fq == 0) sq_[(size_t)row * 32 + u.pn * 4 + wc] = ss;
                }
        } else {
            const bool extra = u.pm >= 32;
            bf16_t* base = O; int ld = ldc, r0 = row0, c0 = col0;
            if (mode == 1) { const int ch = u.pn >> 3; base += (size_t)ch * ((size_t)MTOK * DM); c0 -= ch * DM; }
            if (extra) { const int j = (u.pn - 20) >> 2; base = kvm + (size_t)j * (MMEM * 1024); ld = 1024; r0 = row0 - MTOK; c0 = col0 - AIN - j * 1024; }
#pragma unroll
            for (int ai = 0; ai < 2; ++ai)
#pragma unroll
                for (int m = 0; m < 4; ++m) {
                    const int row = r0 + ai * HALF + m * 16;
                    float rs = 1.f;
                    if (u.pm == pm_tab) rs = ((const LAS float*)(unsigned)RS_OFF)[wr * 64 + fr + ai * HALF + m * 16];
                    else if (!extra) { const f32x4 a = *(const f32x4*)(ssq_in + (size_t)row * 32 + fq * 8), b = *(const f32x4*)(ssq_in + (size_t)row * 32 + fq * 8 + 4);
                        float sq = (a[0] + a[1]) + (a[2] + a[3]) + (b[0] + b[1]) + (b[2] + b[3]);
                        sq += __shfl_xor(sq, 16); sq += __shfl_xor(sq, 32);
                        rs = rsqrtf(sq * (1.f / DM) + EPS); }
                    bf16_t* rowp = base + (size_t)row * ld + c0;
#pragma unroll
                    for (int bj = 0; bj < 2; ++bj) {
                        f32x4 v0 = acc[ai][bj][m][0] * rs, v1 = acc[ai][bj][m][1] * rs;
                        if (mode == 1) {
#pragma unroll
                            for (int j = 0; j < 4; ++j) { const float a = fmaxf(v0[j], 0.f), b = fmaxf(v1[j], 0.f); v0[j] = a * a; v1[j] = b * b; }
                        }
                        u32x4 w; w.x = cvt_pk_bf16(v0[0], v0[1]); w.y = cvt_pk_bf16(v0[2], v0[3]); w.z = cvt_pk_bf16(v1[0], v1[1]); w.w = cvt_pk_bf16(v1[2], v1[3]);
                        *(u32x4*)(rowp + bj * HALF) = w;
                    }
                }
        }
    }
};

__device__ __forceinline__ void gemm_phase(const int tid, LAS unsigned char* lds, const Gemm g, const Sched& S, const Epi& E) {
    const int wid = __builtin_amdgcn_readfirstlane(tid >> 6), lane = tid & 63, wr = wid >> 2, wc = wid & 3, fr = lane & 15, fq = lane >> 4;
    const int K = g.K, nt = K / BK;
    unsigned voffA[2], voffB[2];
#pragma unroll
    for (int i = 0; i < 2; ++i) { int R, C; stage_rc(tid * 16 + i * 8192, R, C); const int Rb = (R & ~31) + perm32(R & 31);
        voffA[i] = (unsigned)(R * DM + C) * 2u; voffB[i] = (unsigned)(Rb * DM + C) * 2u; }
    const size_t kstep = (size_t)(BK * 2);
    const size_t hstep = (size_t)HALF * DM * 2;
    const size_t cstepA = g.cstepA, cstepB = g.cstepB;
#define PG8_OFFA(t) ((size_t)((t) >> 5) * cstepA + (size_t)((t) & 31) * kstep)
#define PG8_OFFB(t) ((size_t)((t) >> 5) * cstepB + (size_t)((t) & 31) * kstep)
    const size_t tstep = 2 * hstep;
    const unsigned ldsw = (unsigned)wid * 1024u;
    const int aoff = lds_byte(wr * 64 + fr, fq * 8), boff = lds_byte(wc * 32 + fr, fq * 8);
#define PG8_SA(b, h) (((b) * 2 + (h)) * HTB)
#define PG8_SB(b, h) ((4 + (b) * 2 + (h)) * HTB)
#define PG8_STAGE(bufoff, gbase, voff) do { _Pragma("unroll") for (int _i = 0; _i < 2; ++_i) \
        __builtin_amdgcn_global_load_lds((const unsigned*)((const char*)(gbase) + (voff)[_i]), (LAS unsigned*)(lds + (bufoff) + ldsw + _i * 8192), 16, 0, 0); } while (0)
#define PG8_LDA(dst, b, h) do { _Pragma("unroll") for (int m = 0; m < 4; ++m) _Pragma("unroll") for (int k = 0; k < 2; ++k) dst[m][k] = *(const LAS bf16x8*)(lds + PG8_SA(b, h) + aoff + m * 2048 + k * 1024); } while (0)
#define PG8_LDB(dst, b, h) do { _Pragma("unroll") for (int n = 0; n < 2; ++n) _Pragma("unroll") for (int k = 0; k < 2; ++k) dst[n][k] = *(const LAS bf16x8*)(lds + PG8_SB(b, h) + boff + n * 2048 + k * 1024); } while (0)
#define PG8_MMA(ai, bj, At, Bt) do { __builtin_amdgcn_s_setprio(1); _Pragma("unroll") for (int m = 0; m < 4; ++m) _Pragma("unroll") for (int n = 0; n < 2; ++n) _Pragma("unroll") for (int k = 0; k < 2; ++k) \
        acc[ai][bj][m][n] = __builtin_amdgcn_mfma_f32_16x16x32_bf16(Bt[n][k], At[m][k], acc[ai][bj][m][n], 0, 0, 0); __builtin_amdgcn_s_setprio(0); } while (0)
#define PG8_WAIT_V(n) asm volatile("s_waitcnt vmcnt(" #n ")" ::: "memory")
#define PG8_WAIT_L(n) asm volatile("s_waitcnt lgkmcnt(" #n ")" ::: "memory")
#define PG8_BAR __builtin_amdgcn_s_barrier()
#define PG8_SCHED __builtin_amdgcn_sched_barrier(0)
    Unit cur, nxt; int ui = 0;
    if (!S.next(0, cur)) return;
    f32x4 acc[2][2][4][2];
#pragma unroll
    for (int a = 0; a < 2; ++a)
#pragma unroll
        for (int b = 0; b < 2; ++b)
#pragma unroll
            for (int m = 0; m < 4; ++m)
#pragma unroll
                for (int n = 0; n < 2; ++n) acc[a][b][m][n] = (f32x4){0.f, 0.f, 0.f, 0.f};
    bf16x8 At[4][2], B0[2][2], B1[2][2];
    const char* cA = (const char*)g.A + (size_t)cur.pm * tstep; const char* cB = (const char*)g.Bt + (size_t)cur.pn * tstep;
    PG8_STAGE(PG8_SB(0, 0), cB, voffB); PG8_STAGE(PG8_SA(0, 0), cA, voffA); PG8_STAGE(PG8_SB(0, 1), cB + hstep, voffB); PG8_STAGE(PG8_SA(0, 1), cA + hstep, voffA);
    if (wr == 1) PG8_BAR;
    PG8_WAIT_V(4); PG8_BAR;
    PG8_STAGE(PG8_SB(1, 0), cB + kstep, voffB); PG8_STAGE(PG8_SA(1, 0), cA + kstep, voffA); PG8_STAGE(PG8_SB(1, 1), cB + hstep + kstep, voffB);
    PG8_WAIT_V(6); PG8_BAR;
    for (;;) {
        const bool has_next = S.next(ui + 1, nxt);
        const char* nA = has_next ? (const char*)g.A + (size_t)nxt.pm * tstep : cA; const char* nB = has_next ? (const char*)g.Bt + (size_t)nxt.pn * tstep : cB;
        for (int t = 0; t < nt; t += 2) {
            const bool last = (t == nt - 2);
            const char* a1 = cA + PG8_OFFA(t + 1);
            const char* a2 = last ? nA : cA + PG8_OFFA(t + 2); const char* b2 = last ? nB : cB + PG8_OFFB(t + 2);
            const char* a3 = a2 + kstep; const char* b3 = b2 + kstep;
            PG8_LDB(B0, 0, 0); PG8_SCHED; PG8_LDA(At, 0, 0); PG8_STAGE(PG8_SA(1, 1), a1 + hstep, voffA);
            PG8_WAIT_L(8); PG8_BAR; PG8_WAIT_L(0); PG8_MMA(0, 0, At, B0); PG8_BAR; PG8_SCHED;
            PG8_LDB(B1, 0, 1); PG8_STAGE(PG8_SB(0, 0), b2, voffB);
            PG8_BAR; PG8_WAIT_L(0); PG8_MMA(0, 1, At, B1); PG8_BAR;
            PG8_LDA(At, 0, 1); PG8_STAGE(PG8_SA(0, 0), a2, voffA);
            PG8_BAR; PG8_WAIT_L(0); PG8_MMA(1, 0, At, B0); PG8_BAR; PG8_SCHED;
            PG8_STAGE(PG8_SB(0, 1), b2 + hstep, voffB);
            PG8_WAIT_V(6); PG8_BAR; PG8_MMA(1, 1, At, B1); PG8_BAR;
            PG8_LDB(B0, 1, 0); PG8_SCHED; PG8_LDA(At, 1, 0); PG8_STAGE(PG8_SA(0, 1), a2 + hstep, voffA);
            PG8_WAIT_L(8); PG8_BAR; PG8_WAIT_L(0); PG8_MMA(0, 0, At, B0); PG8_BAR; PG8_SCHED;
            PG8_LDB(B1, 1, 1); PG8_STAGE(PG8_SB(1, 0), b3, voffB);
            PG8_BAR; PG8_WAIT_L(0); PG8_MMA(0, 1, At, B1); PG8_BAR;
            PG8_LDA(At, 1, 1); PG8_STAGE(PG8_SA(1, 0), a3, voffA);
            PG8_BAR; PG8_WAIT_L(0); PG8_MMA(1, 0, At, B0); PG8_BAR; PG8_SCHED;
            PG8_STAGE(PG8_SB(1, 1), b3 + hstep, voffB);
            PG8_WAIT_V(6); PG8_BAR; PG8_MMA(1, 1, At, B1); PG8_BAR;
        }
        E(acc, cur, wr, wc, fr, fq);
        if (!has_next) break;
#pragma unroll
        for (int a = 0; a < 2; ++a)
#pragma unroll
            for (int b = 0; b < 2; ++b)
#pragma unroll
                for (int m = 0; m < 4; ++m)
#pragma unroll
                    for (int n = 0; n < 2; ++n) acc[a][b][m][n] = (f32x4){0.f, 0.f, 0.f, 0.f};
        cur = nxt; cA = nA; cB = nB; ++ui;
    }
    PG8_WAIT_V(0);
    if (wr == 0) PG8_BAR;
    PG8_BAR;
#undef PG8_OFFA
#undef PG8_OFFB
#undef PG8_SA
#undef PG8_SB
#undef PG8_STAGE
#undef PG8_LDA
#undef PG8_LDB
#undef PG8_MMA
#undef PG8_WAIT_V
#undef PG8_WAIT_L
#undef PG8_BAR
#undef PG8_SCHED
}
}

namespace at {
constexpr int D = 128, NW = 8, QBLK = 32, KVBLK = 64;
constexpr float SCALE = 0.088388347648318440f;
constexpr float THR = 8.f;
constexpr size_t SHM_V = KVBLK * D * 2, SHM_K = KVBLK * D * 2, SHM_ATTN = 2 * SHM_V + 2 * SHM_K + NW * 64 * 4;
constexpr int TB_OFF = (int)SHM_ATTN, TB_FLOATS = 640;
#define KSWZ(row, colB) ((row) * 256 + ((colB) ^ (((row) & 7) << 4)))
#define SBAR() __builtin_amdgcn_sched_barrier(0)
__device__ __forceinline__ int crow(int r, int hi) { return (r & 3) + 8 * (r >> 2) + 4 * hi; }

__device__ __forceinline__ void partialSM(f32x16& p0, f32x16& p1, float& m_reg, float& mn, float& alpha) {
    constexpr float C = SCALE * 1.4426950408889634f;
    float pmax = p0[0];
#pragma unroll
    for (int r = 1; r < 16; ++r) pmax = fmaxf(pmax, p0[r]);
#pragma unroll
    for (int r = 0; r < 16; ++r) pmax = fmaxf(pmax, p1[r]);
    { auto rr = __builtin_amdgcn_permlane32_swap(__float_as_uint(pmax), __float_as_uint(pmax), false, false);
      pmax = fmaxf(__uint_as_float(rr[0]), __uint_as_float(rr[1])); }
    if (__builtin_expect(__all(pmax - m_reg <= THR / SCALE), 1)) { mn = m_reg; alpha = 1.f; }
    else { mn = fmaxf(m_reg, pmax); alpha = __builtin_amdgcn_exp2f((m_reg - mn) * C); m_reg = mn; }
    const float mnC = -mn * C;
#pragma unroll
    for (int r = 0; r < 16; ++r) p0[r] = fmaf(p0[r], C, mnC);
#pragma unroll
    for (int r = 0; r < 16; ++r) p1[r] = fmaf(p1[r], C, mnC);
#pragma unroll
    for (int r = 0; r < 16; ++r) p0[r] = __builtin_amdgcn_exp2f(p0[r]);
}
__device__ __forceinline__ void finishSM(f32x16& p0, f32x16& p1, float alpha, float& l_reg, bf16x8& pa0, bf16x8& pa1, bf16x8& pa2, bf16x8& pa3) {
#pragma unroll
    for (int r = 0; r < 16; ++r) p1[r] = __builtin_amdgcn_exp2f(p1[r]);
    float ps = 0;
#pragma unroll
    for (int r = 0; r < 16; ++r) ps += p0[r];
#pragma unroll
    for (int r = 0; r < 16; ++r) ps += p1[r];
    { auto rr = __builtin_amdgcn_permlane32_swap(__float_as_uint(ps), __float_as_uint(ps), false, false);
      ps = __uint_as_float(rr[0]) + __uint_as_float(rr[1]); }
    l_reg = l_reg * alpha + ps;
#define PK4(P, BASE, OUT) do { unsigned a0 = cvt_pk_bf16(P[BASE + 0], P[BASE + 1]), a1 = cvt_pk_bf16(P[BASE + 2], P[BASE + 3]);   \
    unsigned b0 = cvt_pk_bf16(P[BASE + 4], P[BASE + 5]), b1 = cvt_pk_bf16(P[BASE + 6], P[BASE + 7]);                              \
    auto r0 = __builtin_amdgcn_permlane32_swap(a0, b0, false, false); auto r1 = __builtin_amdgcn_permlane32_swap(a1, b1, false, false); \
    u32x4 w = {r0[0], r1[0], r0[1], r1[1]}; OUT = *reinterpret_cast<bf16x8*>(&w); } while (0)
    PK4(p0, 0, pa0); PK4(p0, 8, pa1); PK4(p1, 0, pa2); PK4(p1, 8, pa3);
#undef PK4
}
__device__ __forceinline__ void qkt(f32x16& p0, f32x16& p1, const bf16_t* Ks, const bf16x8* qr, int r32, int hi) {
    p0 = f32x16{}; p1 = f32x16{};
#pragma unroll
    for (int d0 = 0; d0 < 8; ++d0) { const int cb = (d0 * 16 + hi * 8) * 2;
        bf16x8 b0 = *reinterpret_cast<const bf16x8*>((const char*)Ks + KSWZ(r32, cb));
        bf16x8 b1 = *reinterpret_cast<const bf16x8*>((const char*)Ks + KSWZ(32 + r32, cb));
        p0 = __builtin_amdgcn_mfma_f32_32x32x16_bf16(b0, qr[d0], p0, 0, 0, 0);
        p1 = __builtin_amdgcn_mfma_f32_32x32x16_bf16(b1, qr[d0], p1, 0, 0, 0); }
}
__device__ __forceinline__ int v_st(int k, int c) { const int kk = (k & ~0xC) | ((k & 4) << 1) | ((k & 8) >> 1); return ((kk >> 3) * 4 + (c >> 5)) * 512 + ((kk & 7) * 32 + (c & 31)) * 2; }
__device__ __forceinline__ int v_rd_base(int lane) { return ((lane & 3) << 3) | (((lane >> 2) & 3) << 6) | (((lane >> 4) & 1) << 5) | (((lane >> 5) & 1) << 8); }
constexpr int v_rd_off(int d0, int ks, int half) { return d0 * 512 + ks * 4096 + half * 2048; }
template <int OFF> __device__ __forceinline__ s16x4 tr_read(int vb) {
    s16x4 r; asm volatile("ds_read_b64_tr_b16 %0, %1 offset:%2" : "=&v"(r) : "v"(vb), "i"(OFF) : "memory"); return r;
}
template <int D0> __device__ __forceinline__ void pv_one(f32x16& od, int vb, bf16x8 pa0, bf16x8 pa1, bf16x8 pa2, bf16x8 pa3) {
    const s16x4 l0 = tr_read<v_rd_off(D0, 0, 0)>(vb), h0 = tr_read<v_rd_off(D0, 0, 1)>(vb), l1 = tr_read<v_rd_off(D0, 1, 0)>(vb), h1 = tr_read<v_rd_off(D0, 1, 1)>(vb);
    const s16x4 l2 = tr_read<v_rd_off(D0, 2, 0)>(vb), h2 = tr_read<v_rd_off(D0, 2, 1)>(vb), l3 = tr_read<v_rd_off(D0, 3, 0)>(vb), h3 = tr_read<v_rd_off(D0, 3, 1)>(vb);
    asm volatile("s_waitcnt lgkmcnt(0)" ::: "memory"); SBAR();
#define PK(L, H) (bf16x8){L[0], L[1], L[2], L[3], H[0], H[1], H[2], H[3]}
    od = __builtin_amdgcn_mfma_f32_32x32x16_bf16(pa0, PK(l0, h0), od, 0, 0, 0);
    od = __builtin_amdgcn_mfma_f32_32x32x16_bf16(pa1, PK(l1, h1), od, 0, 0, 0);
    od = __builtin_amdgcn_mfma_f32_32x32x16_bf16(pa2, PK(l2, h2), od, 0, 0, 0);
    od = __builtin_amdgcn_mfma_f32_32x32x16_bf16(pa3, PK(l3, h3), od, 0, 0, 0);
#undef PK
}
__device__ __forceinline__ void pv_d0(f32x16* o, int vb, bf16x8 pa0, bf16x8 pa1, bf16x8 pa2, bf16x8 pa3) {
    pv_one<0>(o[0], vb, pa0, pa1, pa2, pa3); pv_one<1>(o[1], vb, pa0, pa1, pa2, pa3); pv_one<2>(o[2], vb, pa0, pa1, pa2, pa3); pv_one<3>(o[3], vb, pa0, pa1, pa2, pa3);
}
__device__ __forceinline__ void na_hook(f32x16& p0, f32x16& p1, int j, int tlo, int cmpb, const LAS float* tbl) {
    const float NINF = -__builtin_inff();
    const int cb = ((unsigned)(j - tlo) < 8u) ? cmpb : 4096;
    const volatile LAS float* t = tbl + j * 31;
#pragma unroll
    for (int rg = 0; rg < 4; ++rg) {
#pragma unroll
        for (int rr = 0; rr < 4; ++rr) { const int r = rg * 4 + rr, kc = rr + 8 * rg;
            const float b0 = t[kc], b1 = t[kc + 32];
            p0[r] = ((unsigned)(kc + cb) < 16u) ? p0[r] + b0 : NINF;
            p1[r] = ((unsigned)(kc + 32 + cb) < 16u) ? p1[r] + b1 : NINF; }
        SBAR();
    }
}

__device__ __forceinline__ void attn_body(const int tid, const bool NA, const bf16_t* __restrict__ Qb, int ldq, const bf16_t* __restrict__ Kh, const bf16_t* __restrict__ Vh, int ldk,
                                          bf16_t* __restrict__ Ob, int ldo, int NT, char* lds, int tlo, int cmpb, const LAS float* tbl) {
    const int wid = __builtin_amdgcn_readfirstlane(tid >> 6), lane = tid & 63, r32 = lane & 31, hi = lane >> 5;
    bf16_t* V_lds = (bf16_t*)lds; bf16_t* K_lds = (bf16_t*)(lds + 2 * SHM_V);
    float* ws = (float*)(lds + 2 * SHM_V + 2 * SHM_K) + wid * 64; float* li_l = ws; float* al_l = ws + 32;
    float m_reg = -1e30f, l_reg = 0; f32x16 o[4] = {}; bf16x8 qr[8];
    const bf16_t* Qw = Qb + (size_t)(wid * QBLK + r32) * ldq + hi * 8;
#pragma unroll
    for (int d0 = 0; d0 < 8; ++d0) qr[d0] = *reinterpret_cast<const bf16x8*>(Qw + d0 * 16);
    const int sr = tid >> 4, sc = (tid & 15) * 8, vst0 = v_st(sr, sc), vst1 = v_st(32 + sr, sc);
    const int vb0 = (int)(uintptr_t)V_lds + v_rd_base(lane);
    constexpr int SDEPTH = 1;
    struct { bf16x8 vs0, vs1, ks0, ks1; } sr_[SDEPTH];
    const unsigned vo0 = (unsigned)(sr * ldk + sc) * 2u, vo1 = vo0 + (unsigned)(32 * ldk) * 2u;
    const char* Kc = (const char*)Kh; const char* Vc = (const char*)Vh; const size_t tile_b = (size_t)KVBLK * ldk * 2;
#define SLOAD(i, t) do { const char* kb_ = Kc + (size_t)(t) * tile_b; const char* vb_ = Vc + (size_t)(t) * tile_b; \
    sr_[i].vs0 = *reinterpret_cast<const bf16x8*>(vb_ + vo0); sr_[i].vs1 = *reinterpret_cast<const bf16x8*>(vb_ + vo1); \
    sr_[i].ks0 = *reinterpret_cast<const bf16x8*>(kb_ + vo0); sr_[i].ks1 = *reinterpret_cast<const bf16x8*>(kb_ + vo1); } while (0)
#define SWRITE(b, i) do { *(bf16x8*)((char*)V_lds + (b) * SHM_V + vst0) = sr_[i].vs0;          \
    *(bf16x8*)((char*)V_lds + (b) * SHM_V + vst1) = sr_[i].vs1; int kc = sc * 2;               \
    *(bf16x8*)((char*)K_lds + (b) * SHM_K + KSWZ(sr, kc)) = sr_[i].ks0;                       \
    *(bf16x8*)((char*)K_lds + (b) * SHM_K + KSWZ(32 + sr, kc)) = sr_[i].ks1; } while (0)
#define SWAIT() do { if constexpr (SDEPTH == 2) asm volatile("s_waitcnt vmcnt(4)" ::: "memory"); else asm volatile("s_waitcnt vmcnt(0)" ::: "memory"); } while (0)
#define RESC(a) do { if (__any((a) < 1.f)) { if (hi == 0) al_l[r32] = (a); asm volatile("s_waitcnt lgkmcnt(0)" ::: "memory"); \
    _Pragma("unroll") for (int d = 0; d < 4; ++d) _Pragma("unroll") for (int r = 0; r < 16; ++r) o[d][r] *= al_l[crow(r, hi)]; } } while (0)
#define HOOK(P0, P1, J) do { if (NA) na_hook(P0, P1, (J), tlo, cmpb, tbl); } while (0)
    f32x16 pA0, pA1, pB0, pB1; float mnA, mnB, alA, alB; bf16x8 pa0, pa1, pa2, pa3;
    constexpr int SE = 0, SO = SDEPTH - 1;
    SLOAD(SE, 0); asm volatile("s_waitcnt vmcnt(0)" ::: "memory"); SWRITE(0, SE); __syncthreads();
    qkt(pA0, pA1, K_lds, qr, r32, hi); HOOK(pA0, pA1, 0); partialSM(pA0, pA1, m_reg, mnA, alA);
    SLOAD(SO, 1); if constexpr (SDEPTH == 2) { if (2 < NT) SLOAD(SE, 2); }
    SWAIT(); SWRITE(1, SO); __syncthreads();
    for (int j = 1; j + 1 < NT; j += 2) {
        SBAR(); qkt(pB0, pB1, (bf16_t*)((char*)K_lds + SHM_K), qr, r32, hi); HOOK(pB0, pB1, j);
        finishSM(pA0, pA1, alA, l_reg, pa0, pa1, pa2, pa3); SBAR();
        SLOAD(SO, j + SDEPTH); SBAR();
        pv_d0(o, vb0, pa0, pa1, pa2, pa3); partialSM(pB0, pB1, m_reg, mnB, alB);
        __syncthreads(); SWAIT(); SWRITE(0, SE);
        RESC(alB); __syncthreads();
        SBAR(); qkt(pA0, pA1, K_lds, qr, r32, hi); HOOK(pA0, pA1, j + 1);
        finishSM(pB0, pB1, alB, l_reg, pa0, pa1, pa2, pa3); SBAR();
        if (SDEPTH == 1 || j + 3 < NT) SLOAD(SE, j + 1 + SDEPTH); SBAR();
        pv_d0(o, vb0 + (int)SHM_V, pa0, pa1, pa2, pa3); partialSM(pA0, pA1, m_reg, mnA, alA);
        __syncthreads(); SWAIT(); SWRITE(1, SO);
        RESC(alA); __syncthreads();
    }
    SBAR(); qkt(pB0, pB1, (bf16_t*)((char*)K_lds + SHM_K), qr, r32, hi); HOOK(pB0, pB1, NT - 1);
    finishSM(pA0, pA1, alA, l_reg, pa0, pa1, pa2, pa3); SBAR();
    pv_d0(o, vb0, pa0, pa1, pa2, pa3); partialSM(pB0, pB1, m_reg, mnB, alB);
    __syncthreads(); RESC(alB);
    finishSM(pB0, pB1, alB, l_reg, pa0, pa1, pa2, pa3); SBAR();
    pv_d0(o, vb0 + (int)SHM_V, pa0, pa1, pa2, pa3);
    if (hi == 0) li_l[r32] = l_reg; asm volatile("s_waitcnt lgkmcnt(0)" ::: "memory");
    float rli[16];
#pragma unroll
    for (int r = 0; r < 16; ++r) rli[r] = __builtin_amdgcn_rcpf(li_l[crow(r, hi)]);
    bf16_t* Ow = Ob + (size_t)(wid * QBLK) * ldo;
#pragma unroll
    for (int r = 0; r < 16; ++r) { const int orow = crow(r, hi);
#pragma unroll
        for (int d0 = 0; d0 < 4; ++d0) Ow[(size_t)orow * ldo + d0 * 32 + r32] = (bf16_t)(cvt_pk_bf16(o[d0][r] * rli[r], 0.f) & 0xffffu); }
#undef SLOAD
#undef SWRITE
#undef SWAIT
#undef RESC
#undef HOOK
}
}

__device__ __forceinline__ void wt_tile(const float* __restrict__ W, int N, bf16_t* __restrict__ Bt, int ldb, const float* __restrict__ g, int tk, int tn, unsigned* s, const int tid) {
    const int kp = tid >> 5, n4 = (tid & 31) * 4;
    f32x4 a[4], b[4];
#pragma unroll
    for (int pass = 0; pass < 4; ++pass) {
        const int k = tk * 128 + (pass * 16 + kp) * 2;
        const float* src = W + (size_t)k * N + tn * 128 + n4;
        a[pass] = __builtin_nontemporal_load((const f32x4*)src); b[pass] = __builtin_nontemporal_load((const f32x4*)(src + N));
    }
#pragma unroll
    for (int pass = 0; pass < 4; ++pass) {
        const int kpp = pass * 16 + kp, k = tk * 128 + kpp * 2;
        const float g0 = g ? g[k] : 1.f, g1 = g ? g[k + 1] : 1.f;
        s[(n4 + 0) * 65 + kpp] = cvt_pk_bf16(a[pass][0] * g0, b[pass][0] * g1);
        s[(n4 + 1) * 65 + kpp] = cvt_pk_bf16(a[pass][1] * g0, b[pass][1] * g1);
        s[(n4 + 2) * 65 + kpp] = cvt_pk_bf16(a[pass][2] * g0, b[pass][2] * g1);
        s[(n4 + 3) * 65 + kpp] = cvt_pk_bf16(a[pass][3] * g0, b[pass][3] * g1);
    }
    __syncthreads();
    const int ks = tid & 15;
#pragma unroll
    for (int pass = 0; pass < 4; ++pass) {
        const int n = pass * 32 + (tid >> 4);
        u32x4 w; w.x = s[n * 65 + ks * 4 + 0]; w.y = s[n * 65 + ks * 4 + 1]; w.z = s[n * 65 + ks * 4 + 2]; w.w = s[n * 65 + ks * 4 + 3];
        *(u32x4*)(Bt + (size_t)(tn * 128 + n) * ldb + ks * 8) = w;
    }
    __syncthreads();
}

__device__ __forceinline__ void prep_phase(const int tid, CParams* pp, unsigned char* shm) {
    const int lane = tid & 63, wid = tid >> 6;
    const int gw = blockIdx.x * 8 + wid, nw = gridDim.x * 8;
    for (int row = gw; row < MTOK; row += nw) {
        const float* xr = pp->x + (size_t)row * DM; bf16_t* hr = pp->acomb + (size_t)row * DM; float s = 0.f;
#pragma unroll
        for (int i = 0; i < 4; ++i) { const int c = (i * 64 + lane) * 8;
            const f32x4 a = *(const f32x4*)(xr + c), b = *(const f32x4*)(xr + c + 4);
            s += a[0] * a[0] + a[1] * a[1] + a[2] * a[2] + a[3] * a[3] + b[0] * b[0] + b[1] * b[1] + b[2] * b[2] + b[3] * b[3];
            u32x4 w; w.x = cvt_pk_bf16(a[0], a[1]); w.y = cvt_pk_bf16(a[2], a[3]); w.z = cvt_pk_bf16(b[0], b[1]); w.w = cvt_pk_bf16(b[2], b[3]);
            *(u32x4*)(hr + c) = w; }
        s += __shfl_xor(s, 32);
        if (lane < 32) pp->ssq[(size_t)row * 32 + lane] = s;
    }
    for (int row = gw; row < MMEM; row += nw) {
        const float* xr = pp->mem + (size_t)row * DM; bf16_t* hr = pp->acomb + (size_t)(MTOK + row) * DM; float s = 0.f;
        f32x4 a[4], b[4];
#pragma unroll
        for (int i = 0; i < 4; ++i) { const int c = (i * 64 + lane) * 8; a[i] = *(const f32x4*)(xr + c); b[i] = *(const f32x4*)(xr + c + 4);
            s += a[i][0] * a[i][0] + a[i][1] * a[i][1] + a[i][2] * a[i][2] + a[i][3] * a[i][3] + b[i][0] * b[i][0] + b[i][1] * b[i][1] + b[i][2] * b[i][2] + b[i][3] * b[i][3]; }
        s = wave_sum(s);
        const float rs = rsqrtf(s * (1.f / DM) + EPS);
#pragma unroll
        for (int i = 0; i < 4; ++i) { const int c = (i * 64 + lane) * 8;
            const f32x4 ga = *(const f32x4*)(pp->mem_norm + c), gb = *(const f32x4*)(pp->mem_norm + c + 4);
            u32x4 w; w.x = cvt_pk_bf16(a[i][0] * rs * ga[0], a[i][1] * rs * ga[1]); w.y = cvt_pk_bf16(a[i][2] * rs * ga[2], a[i][3] * rs * ga[3]);
            w.z = cvt_pk_bf16(b[i][0] * rs * gb[0], b[i][1] * rs * gb[1]); w.w = cvt_pk_bf16(b[i][2] * rs * gb[2], b[i][3] * rs * gb[3]);
            *(u32x4*)(hr + c) = w; }
    }
}

__device__ __forceinline__ void convert_jobs(const int tid, CParams* pp, unsigned char* shm, const int mask, const int rank, const int nranks) {
    unsigned* s = (unsigned*)shm;
    int t = rank;
#pragma unroll 1
    for (int job = 0; job < 10; ++job) {
        if (!((mask >> job) & 1)) continue;
        const float* W; const float* g = nullptr; bf16_t* Bt; int K = DM, N;
        switch (job) {
            case 0: W = pp->a_w_in; N = AIN; Bt = pp->wt_in0; g = pp->attn_norm; break;
            case 1: W = pp->w_mem_kv; N = 1024; Bt = pp->wt_in0 + (size_t)AIN * DM; break;
            case 2: W = pp->w_mem_kv + (size_t)DM * 1024; N = 1024; Bt = pp->wt_in0 + (size_t)(AIN + 1024) * DM; break;
            case 3: W = pp->b_w_in; N = BIN; Bt = pp->wt_in1; g = pp->attn_norm + DM; break;
            case 4: W = pp->w_o; N = DM; Bt = pp->wt_o; break;
            case 5: W = pp->w_o + (size_t)DM * DM; N = DM; Bt = pp->wt_o + (size_t)DM * DM; break;
            case 6: W = pp->w_up; N = DFF; Bt = pp->wt_up; g = pp->mlp_norm; break;
            case 7: W = pp->w_up + (size_t)DM * DFF; N = DFF; Bt = pp->wt_up + (size_t)DM * DFF; g = pp->mlp_norm + DM; break;
            case 8: W = pp->w_down; K = DFF; N = DM; Bt = pp->wt_down; break;
            default: W = pp->w_down + (size_t)DFF * DM; K = DFF; N = DM; Bt = pp->wt_down + (size_t)DFF * DM; break;
        }
        const int ntn = N / 128, ntiles = (K / 128) * ntn;
        for (; t < ntiles; t += nranks) { const int tk = t / ntn, k0 = tk * 128;
            bf16_t* dst = (K == DFF) ? Bt + (size_t)(k0 >> 11) * ((size_t)DM * DM) + (k0 & (DM - 1)) : Bt + k0;
            wt_tile(W, N, dst, DM, g, tk, t % ntn, s, tid); }
        t -= ntiles;
    }
}

__device__ __forceinline__ void qknorm_rope_phase(const int tid, CParams* pp) {
    const int lane = tid & 63, wid = tid >> 6, l16 = lane & 15;
    const int head = (wid & 3) * 4 + (lane >> 4);
    const float* gsrc = (head < 12 ? pp->b_q_norm : pp->b_k_norm) + l16 * 8;
    float gn[8];
#pragma unroll
    for (int i = 0; i < 8; ++i) gn[i] = gsrc[i];
    float fr[8];
#pragma unroll
    for (int i = 0; i < 8; ++i) { const int fi = (l16 & 3) * 8 + i; fr[i] = exp2f(-(float)fi * (13.287712379549449f / 32.f)) * 0.15915494309189535f; }
    const bool colsec = (l16 >> 3) != 0, x1lane = (l16 & 4) == 0;
    for (int row = blockIdx.x * 2 + (wid >> 2); row < MTOK; row += gridDim.x * 2) {
        bf16_t* ptr = pp->z + (size_t)row * BIN + head * HD + l16 * 8;
        const u32x4 w = *(const u32x4*)ptr;
        float v[8] = {bf_lo(w.x), bf_hi(w.x), bf_lo(w.y), bf_hi(w.y), bf_lo(w.z), bf_hi(w.z), bf_lo(w.w), bf_hi(w.w)};
        float ss = 0.f;
#pragma unroll
        for (int i = 0; i < 8; ++i) ss += v[i] * v[i];
        ss += __shfl_xor(ss, 1); ss += __shfl_xor(ss, 2); ss += __shfl_xor(ss, 4); ss += __shfl_xor(ss, 8);
        const float rs = rsqrtf(ss * (1.f / HD) + EPS);
        const int tpos = row & (SEQ - 1);
        const float pos = (float)(colsec ? (tpos & 63) : (tpos >> 6));
        float o[8];
#pragma unroll
        for (int i = 0; i < 8; ++i) {
            const float y = v[i] * rs * gn[i];
            const float py = __shfl_xor(y, 4);
            float rev = pos * fr[i]; rev -= floorf(rev);
            const float sn = __builtin_amdgcn_sinf(rev), cs = __builtin_amdgcn_cosf(rev);
            o[i] = x1lane ? (y * cs - py * sn) : (y * cs + py * sn);
        }
        u32x4 r; r.x = cvt_pk_bf16(o[0], o[1]); r.y = cvt_pk_bf16(o[2], o[3]); r.z = cvt_pk_bf16(o[4], o[5]); r.w = cvt_pk_bf16(o[6], o[7]);
        *(u32x4*)ptr = r;
    }
}

__device__ __forceinline__ void final_phase(const int tid, CParams* pp) {
    const int lane = tid & 63, wid = tid >> 6;
    for (int row = blockIdx.x * 8 + wid; row < MTOK; row += gridDim.x * 8) {
        const bf16_t* hr = pp->hb2 + (size_t)row * DM; float* orow = pp->out + (size_t)row * DM;
        u32x4 w[4]; float ss = 0.f;
#pragma unroll
        for (int i = 0; i < 4; ++i) { w[i] = *(const u32x4*)(hr + (i * 64 + lane) * 8);
            const float a0 = bf_lo(w[i].x), a1 = bf_hi(w[i].x), a2 = bf_lo(w[i].y), a3 = bf_hi(w[i].y), a4 = bf_lo(w[i].z), a5 = bf_hi(w[i].z), a6 = bf_lo(w[i].w), a7 = bf_hi(w[i].w);
            ss += a0 * a0 + a1 * a1 + a2 * a2 + a3 * a3 + a4 * a4 + a5 * a5 + a6 * a6 + a7 * a7; }
        const float rs = rsqrtf(wave_sum(ss) * (1.f / DM) + EPS);
#pragma unroll
        for (int i = 0; i < 4; ++i) { const int c = (i * 64 + lane) * 8;
            const f32x4 g0 = *(const f32x4*)(pp->final_norm + c), g1 = *(const f32x4*)(pp->final_norm + c + 4);
            f32x4 o0, o1;
            o0[0] = bf_lo(w[i].x) * rs * g0[0]; o0[1] = bf_hi(w[i].x) * rs * g0[1]; o0[2] = bf_lo(w[i].y) * rs * g0[2]; o0[3] = bf_hi(w[i].y) * rs * g0[3];
            o1[0] = bf_lo(w[i].z) * rs * g1[0]; o1[1] = bf_hi(w[i].z) * rs * g1[1]; o1[2] = bf_lo(w[i].w) * rs * g1[2]; o1[3] = bf_hi(w[i].w) * rs * g1[3];
            *(f32x4*)(orow + c) = o0; *(f32x4*)(orow + c + 4) = o1; }
    }
}
__device__ __forceinline__ void attn_phase(const int tid, CParams* pp, int layer, unsigned char* shm) {
    const int wid = __builtin_amdgcn_readfirstlane(tid >> 6), lane = tid & 63, r32 = lane & 31, hi = lane >> 5;
    const int xcd = blockIdx.x & 7, nper = gridDim.x >> 3;
    const int ldz = layer ? BIN : AIN, qmoff = layer ? 2560 : 4608;
    LAS float* tb = (LAS float*)((LAS unsigned char*)shm + at::TB_OFF);
    for (int i = blockIdx.x >> 3; i < 64; i += nper) {
        __syncthreads();
        const bf16_t *Q, *Kp, *Vp; bf16_t* O; int ldq = ldz, ldk, NT, tlo = 0, cmpb = 0; bool na = false; const LAS float* tbl = tb;
        if (i >= 48) {
            const int midx = xcd * 16 + (i - 48), b = midx >> 5, hm = (midx >> 3) & 3, qb = midx & 7;
            const size_t q0 = (size_t)(b * SEQ + qb * 256);
            Q = pp->z + q0 * ldz + qmoff + hm * HD;
            Kp = pp->kvm + (size_t)layer * (MMEM * 1024) + (size_t)(b * NMEM) * 1024 + hm * HD; Vp = Kp + 512; ldk = 1024; NT = 4;
            O = pp->cat + q0 * DM + 1536 + hm * HD;
        } else if (layer == 0) {
            const int group = xcd + 8 * (i >> 3), b = group / 12, h = group % 12, qb = i & 7;
            int kr0 = 4 * qb - 4; kr0 = kr0 < 0 ? 0 : (kr0 > 24 ? 24 : kr0);
            NT = (qb == 0 || qb == 7) ? 8 : 12; na = true;
            for (int e = tid; e < at::TB_FLOATS; e += 512) { const int k = e - 64; tb[e] = (k >= 0 && k < 465) ? pp->a_rpb[h * 465 + k] * 11.313708498984761f : 0.f; }
            __syncthreads();
            const int rq = 4 * qb + (wid >> 1), c = (wid & 1) * 32 + r32;
            int r0w = rq - 4; r0w = r0w < 0 ? 0 : (r0w > 24 ? 24 : r0w);
            int c0 = c - 8; c0 = c0 < 0 ? 0 : (c0 > 48 ? 48 : c0);
            tlo = r0w - kr0; cmpb = 4 * hi - c0;
            tbl = tb + 64 + (kr0 - rq + 7) * 31 + 15 - c + 4 * hi;
            const size_t q0 = (size_t)(b * SEQ + qb * 256), k0 = (size_t)(b * SEQ + kr0 * 64);
            Q = pp->z + q0 * AIN + h * HD;
            Kp = pp->z + k0 * AIN + 1536 + h * HD; Vp = Kp + 1536; ldk = AIN;
            O = pp->cat + q0 * DM + h * HD;
        } else {
            const int group = xcd + 8 * (i / 24), b = group >> 2, kvh = group & 3, w = i % 24, hq = kvh * 3 + (w >> 3), qb = w & 7;
            const size_t q0 = (size_t)(b * SEQ + qb * 256), k0 = (size_t)(b * SEQ);
            Q = pp->z + q0 * BIN + hq * HD;
            Kp = pp->z + k0 * BIN + 1536 + kvh * HD; Vp = Kp + 512; ldk = BIN; NT = 32;
            O = pp->cat + q0 * DM + hq * HD;
        }
        at::attn_body(tid, na, Q, ldq, Kp, Vp, ldk, O, DM, NT, (char*)shm, tlo, cmpb, tbl);
    }
}

#define XB_TMO      128
#define XB_XCNT(j)  (256  + 64 * (j))
#define XB_XSUB(j)  (1280 + 64 * (j))
#define XB_XGEN(j)  (2304 + 64 * (j))
#define XB_TOP      3328
#define XB_TOPGEN   3392
#define XCD_BAR_WORDS 3456
#define XB_SPIN_CAP (1u << 18)
__device__ __forceinline__ unsigned xb_ld(unsigned* p)              { return __hip_atomic_load(p, __ATOMIC_RELAXED, __HIP_MEMORY_SCOPE_AGENT); }
__device__ __forceinline__ unsigned xb_add(unsigned* p, unsigned v) { return __hip_atomic_fetch_add(p, v, __ATOMIC_RELAXED, __HIP_MEMORY_SCOPE_AGENT); }
__device__ __forceinline__ unsigned xb_xcc_id() { return (unsigned)__builtin_amdgcn_s_getreg((3 << 11) | 20) & 0xFu; }
#define XB_SPIN(cond, bar) do { unsigned _sp = 0; while (cond) { __builtin_amdgcn_s_sleep(1); \
    if ((++_sp & 255u) == 0u) { if (xb_ld(&(bar)[XB_TMO])) break; if (_sp > XB_SPIN_CAP) { atomicAdd(&(bar)[XB_TMO], 1u); break; } } } } while (0)
struct XcdBarrier { unsigned* bar; unsigned x; volatile LAS unsigned* st; };
__device__ __forceinline__ XcdBarrier xcd_barrier_post(unsigned* bar, volatile LAS unsigned* st) {
    XcdBarrier b; b.bar = bar; b.x = xb_xcc_id(); b.st = st;
    if (threadIdx.x == 0) (void)xb_add(&bar[XB_XCNT(b.x)], 1u);
    return b;
}
__device__ __forceinline__ void xcd_barrier_complete(unsigned* bar, unsigned x, unsigned& nloc, unsigned& nx) {
    const unsigned G = gridDim.x * gridDim.y * gridDim.z;
    unsigned sum, cnt, mine, sp = 0u;
    for (;;) {
        sum = 0u; cnt = 0u; mine = 0u;
#pragma unroll
        for (unsigned j = 0; j < 16; ++j) { const unsigned c = xb_ld(&bar[XB_XCNT(j)]); sum += c; cnt += (c > 0u) ? 1u : 0u; mine = (j == x) ? c : mine; }
        if (sum == G) break;
        __builtin_amdgcn_s_sleep(1);
        if ((++sp & 255u) == 0u) { if (xb_ld(&bar[XB_TMO])) break; if (sp > XB_SPIN_CAP) { atomicAdd(&bar[XB_TMO], 1u); break; } }
    }
    nloc = mine > 0u ? mine : 1u; nx = cnt > 0u ? cnt : 1u;
}
__device__ __forceinline__ void xcd_barrier(const XcdBarrier& b) {
    asm volatile("s_waitcnt vmcnt(0)" ::: "memory");
    __syncthreads();
    if (threadIdx.x == 0) {
        unsigned* bar = b.bar;
        __builtin_amdgcn_s_waitcnt(0);
        unsigned nloc = b.st[0], nx = b.st[1];
        if (nloc == 0u) { xcd_barrier_complete(bar, b.x, nloc, nx); b.st[0] = nloc; b.st[1] = nx; }
        const unsigned old = xb_add(&bar[XB_XSUB(b.x)], 1u);
        const unsigned gen = old / nloc;
        if (old + 1u == (gen + 1u) * nloc) {
            __builtin_amdgcn_fence(__ATOMIC_RELEASE, "agent");
            asm volatile("s_waitcnt vmcnt(0)" ::: "memory");
            const unsigned og = xb_add(&bar[XB_TOP], 1u);
            const unsigned tg = og / nx;
            if (og + 1u == (tg + 1u) * nx) xb_add(&bar[XB_TOPGEN], 1u);
            else XB_SPIN(xb_ld(&bar[XB_TOPGEN]) == tg, bar);
            __builtin_amdgcn_fence(__ATOMIC_ACQUIRE, "agent");
            xb_add(&bar[XB_XGEN(b.x)], 1u);
            asm volatile("s_waitcnt vmcnt(0)" ::: "memory");
        } else {
            XB_SPIN(xb_ld(&bar[XB_XGEN(b.x)]) == gen, bar);
            __builtin_amdgcn_fence(__ATOMIC_ACQUIRE, "agent");
            asm volatile("s_waitcnt vmcnt(0)" ::: "memory");
        }
    }
    __syncthreads();
}

__global__ void __launch_bounds__(512) mega(Params p, int ph_lo, int ph_hi) {
    extern __shared__ __attribute__((aligned(16))) unsigned char shm[];
    cg::grid_group grid = cg::this_grid();
    volatile LAS unsigned* xst = (volatile LAS unsigned*)((LAS unsigned char*)shm + 131072);
    if (threadIdx.x == 0) { xst[0] = 0u; xst[1] = 0u; }
    __syncthreads();
    (void)xcd_barrier_post(((CParams*)__builtin_amdgcn_kernarg_segment_ptr())->bar, xst);
    for (int ph = ph_lo; ph < ph_hi; ++ph) {
        int tid = threadIdx.x; asm volatile("" : "+v"(tid));
        CParams* pp = (CParams*)__builtin_amdgcn_kernarg_segment_ptr(); asm volatile("" : "+s"(pp));
        if (ph == 0) prep_phase(tid, pp, shm);
        else if (ph == 2 || ph == 8) attn_phase(tid, pp, ph == 8, shm);
        else if (ph == 7) qknorm_rope_phase(tid, pp);
        else if (ph == 12) final_phase(tid, pp);
        else {
            pg8::Gemm g; pg8::Sched S; pg8::Epi E;
            const int layer = ph >= 6;
            E.pp = pp; E.ph = ph; E.pm_tab = -1;
            if (ph == 1 || ph == 4 || ph == 6 || ph == 10) {
                pg8::Unit u0; pg8::Sched S0; S0.init(32, ph == 1 ? 20 : (ph == 6 ? 12 : 32), (int)gridDim.x, (int)blockIdx.x);
                if (S0.next(0, u0) && u0.pm < 32) {
                    const float* sp = pp->ssq + (size_t)(ph == 1 ? 0 : (ph == 6 ? 2 : (ph == 4 ? 1 : 3))) * MTOK * 32 + ((size_t)u0.pm * 256 + (tid >> 1)) * 32 + (tid & 1) * 16;
                    const f32x4 a = *(const f32x4*)sp, b = *(const f32x4*)(sp + 4), c = *(const f32x4*)(sp + 8), d = *(const f32x4*)(sp + 12);
                    float sq = ((a[0] + a[1]) + (a[2] + a[3])) + ((b[0] + b[1]) + (b[2] + b[3])) + ((c[0] + c[1]) + (c[2] + c[3])) + ((d[0] + d[1]) + (d[2] + d[3]));
                    sq += __shfl_xor(sq, 1);
                    if ((tid & 1) == 0) ((LAS float*)((LAS unsigned char*)shm + RS_OFF))[tid >> 1] = rsqrtf(sq * (1.f / DM) + EPS);
                    E.pm_tab = u0.pm;
                }
                __syncthreads();
            }
            g.A = pp->acomb; g.K = DM; g.cstepA = 0; g.cstepB = 0;
            int nN = 8;
            if (ph == 1) { g.Bt = pp->wt_in0; nN = 20; }
            else if (ph == 6) { g.A = pp->hb2; g.Bt = pp->wt_in1; nN = 12; }
            else if (ph == 3 || ph == 9) { g.A = pp->cat; g.Bt = pp->wt_o + (size_t)layer * DM * DM; }
            else if (ph == 4 || ph == 10) { g.Bt = pp->wt_up + (size_t)layer * DM * DFF; nN = 32; }
            else { g.A = pp->u; g.K = DFF; g.cstepA = (size_t)MTOK * DM * 2; g.cstepB = (size_t)DM * DM * 2; g.Bt = pp->wt_down + (size_t)layer * DM * DFF; }
            S.init(32, nN, (int)gridDim.x, (int)blockIdx.x);
            if (ph == 1) { S.xM0 = 32; S.xnM = 4; S.xN0 = 20; S.nx = 32; }
            pg8::gemm_phase(tid, (LAS unsigned char*)shm, g, S, E);
        }
        {
            const int G = (int)gridDim.x, c = (int)blockIdx.x;
            int m0 = 0, r0 = 0, n0 = 1, m1 = 0, r1 = 0, n1 = 1;
            if (G != 256) { if (ph == 0) { m0 = 0x3FF; r0 = c; n0 = G; } }
            else if (ph == 0) { m0 = 0x007; r0 = c; n0 = 256; }
            else if (ph == 1 && c >= 160) { m0 = 0x050; r0 = c - 160; n0 = 96; m1 = 0x100; r1 = c - 160; n1 = 224; }
            else if (ph == 2 && (c >> 3) >= 16) { const int r = ((c >> 3) - 16) * 8 + (c & 7); m0 = 0x008; r0 = r; n0 = 128; m1 = 0x100; r1 = 96 + r; n1 = 224; }
            else if (ph == 6 && c >= 128) { m0 = 0x020; r0 = c - 128; n0 = 128; }
            else if (ph == 8 && (c >> 3) >= 16) { m0 = 0x280; r0 = ((c >> 3) - 16) * 8 + (c & 7); n0 = 128; }
            if (m0 | m1) {
                __syncthreads();
#pragma unroll 1
                for (int it = 0; it < 2; ++it) { const int cm = it ? m1 : m0; if (cm) convert_jobs(tid, pp, shm, cm, it ? r1 : r0, it ? n1 : n0); }
            }
        }
        if (ph + 1 < ph_hi) {
            if (ph_lo != 0) grid.sync();
            else { CParams* q = (CParams*)__builtin_amdgcn_kernarg_segment_ptr(); asm volatile("" : "+s"(q));
                   XcdBarrier xb_; xb_.bar = q->bar; xb_.x = xb_xcc_id(); xb_.st = (volatile LAS unsigned*)((LAS unsigned char*)shm + 131072); xcd_barrier(xb_); }
        }
    }
}

extern "C" void kernel_launch(void* const* d_in, const int* in_sizes, int n_in, void* d_out, int out_size, void* d_ws, size_t ws_size, hipStream_t stream) {
    constexpr size_t MiB = 1ull << 20;
    constexpr size_t O_WIN0 = 0, O_WIN1 = O_WIN0 + 28 * MiB, O_WO = O_WIN1 + 12 * MiB, O_WUP = O_WO + 16 * MiB, O_WDN = O_WUP + 64 * MiB,
                     O_ACOMB = O_WDN + 64 * MiB, O_R = O_ACOMB + 36 * MiB, O_U = O_R + 112 * MiB, O_KVM = O_U + 128 * MiB, O_SSQ = O_KVM + 4 * MiB, O_HB2 = O_SSQ + 8 * MiB, O_END = O_HB2 + 32 * MiB;
    static int grid_blocks = 0;
    if (grid_blocks == 0) {
        const long long expect[15] = {(long long)MTOK * DM, (long long)MMEM * DM, DM, 2 * DM, 2 * DM, (long long)DM * AIN, 12 * 15 * 31, (long long)DM * BIN, HD, HD,
                                      2LL * DM * 1024, 2LL * DM * DM, 2LL * DM * DFF, 2LL * DFF * DM, DM};
        bool bad = n_in != 15;
        for (int i = 0; i < 15 && !bad; ++i) bad = (long long)in_sizes[i] != expect[i];
        if (bad || in_sizes[0] != MTOK * DM || out_size != MTOK * DM || ws_size < O_END) {
            fprintf(stderr, "kernel_launch: unexpected shapes (n_in %d, in0 %d, out %d, ws %zu; need ws >= %zu)\n", n_in, n_in > 0 ? in_sizes[0] : -1, out_size, ws_size, (size_t)O_END);
            grid_blocks = -1; return; }
        int dev = 0, cus = 0, per_cu = 0;
        hipGetDevice(&dev);
        hipDeviceGetAttribute(&cus, hipDeviceAttributeMultiprocessorCount, dev);
        if (hipFuncSetAttribute((const void*)mega, hipFuncAttributeMaxDynamicSharedMemorySize, LDS_BYTES) != hipSuccess) { fprintf(stderr, "kernel_launch: hipFuncSetAttribute failed\n"); grid_blocks = -1; return; }
        if (hipOccupancyMaxActiveBlocksPerMultiprocessor(&per_cu, (const void*)mega, 512, LDS_BYTES) != hipSuccess || per_cu < 1) { fprintf(stderr, "kernel_launch: occupancy query gave %d\n", per_cu); per_cu = 1; (void)hipGetLastError(); }
        grid_blocks = (cus * per_cu) & ~7;
        if (grid_blocks > 256) grid_blocks = 256;
    }
    if (grid_blocks < 0) return;
    Params hp{};
    hp.x = (const float*)d_in[0]; hp.mem = (const float*)d_in[1]; hp.mem_norm = (const float*)d_in[2]; hp.attn_norm = (const float*)d_in[3]; hp.mlp_norm = (const float*)d_in[4];
    hp.a_w_in = (const float*)d_in[5]; hp.a_rpb = (const float*)d_in[6]; hp.b_w_in = (const float*)d_in[7]; hp.b_q_norm = (const float*)d_in[8]; hp.b_k_norm = (const float*)d_in[9];
    hp.w_mem_kv = (const float*)d_in[10]; hp.w_o = (const float*)d_in[11]; hp.w_up = (const float*)d_in[12]; hp.w_down = (const float*)d_in[13]; hp.final_norm = (const float*)d_in[14];
    hp.out = (float*)d_out;
    char* ws = (char*)d_ws;
    hp.wt_in0 = (bf16_t*)(ws + O_WIN0); hp.wt_in1 = (bf16_t*)(ws + O_WIN1); hp.wt_o = (bf16_t*)(ws + O_WO); hp.wt_up = (bf16_t*)(ws + O_WUP); hp.wt_down = (bf16_t*)(ws + O_WDN);
    hp.acomb = (bf16_t*)(ws + O_ACOMB); hp.z = (bf16_t*)(ws + O_R); hp.cat = (bf16_t*)(ws + O_R + 80 * MiB); hp.u = (bf16_t*)(ws + O_U); hp.kvm = (bf16_t*)(ws + O_KVM);
    hp.ssq = (float*)(ws + O_SSQ); hp.hb2 = (bf16_t*)(ws + O_HB2); hp.bar = (unsigned*)(ws + O_SSQ + 7 * MiB);
    if (hipMemsetAsync(hp.bar, 0, XCD_BAR_WORDS * sizeof(unsigned), stream) != hipSuccess) { fprintf(stderr, "kernel_launch: hipMemsetAsync failed\n"); return; }
#if MK_ONE_LAUNCH
    int lo = 0, hi = NPHASE;
    void* args[] = {&hp, &lo, &hi};
    hipError_t e = hipLaunchCooperativeKernel((const void*)mega, dim3(grid_blocks), dim3(512), args, LDS_BYTES, stream);
    if (e != hipSuccess) fprintf(stderr, "kernel_launch: cooperative launch failed: %s (grid %d)\n", hipGetErrorString(e), grid_blocks);
#else
    for (int ph = 0; ph < NPHASE; ++ph) {
        hipLaunchKernelGGL(mega, dim3(grid_blocks), dim3(512), LDS_BYTES, stream, hp, ph, ph + 1);
    }
    const hipError_t le = hipPeekAtLastError();
    if (le != hipSuccess) fprintf(stderr, "kernel_launch: launch failed: %s\n", hipGetErrorName(le));
#endif
}
```
